# Optimizing an MI355X kernel written in HIP

```python
import math
import jax, jax.numpy as jnp
from jax import lax
import numpy as np

D_MODEL = 1024
BATCH = 8
SEQ = 4096
DEPTH = 2

MEM_LEN = 256
BLOCK = 128
DIFF_HEADS = 8
DIFF_DK = 64
DIFF_DV = 2 * DIFF_DK
SWA_HEADS = 8
SWA_KV_HEADS = 2
SWA_HD = 64
WINDOW = 128
MEM_HEADS = 4
MEM_HD = 128
N_BRANCH = 3
D_FF = 2816
NEG_INF = -1e30
EPS = 1e-6

DIFF_QK_W = DIFF_HEADS * 2 * DIFF_DK
DIFF_V_W = DIFF_HEADS * DIFF_DV
SWA_Q_W = SWA_HEADS * SWA_HD
SWA_KV_W = SWA_KV_HEADS * SWA_HD
MEM_Q_W = MEM_HEADS * MEM_HD
GATE_W = N_BRANCH * D_MODEL
IN_SIZES = [DIFF_QK_W, DIFF_QK_W, DIFF_V_W, SWA_Q_W, SWA_KV_W, SWA_KV_W, MEM_Q_W, GATE_W]
IN_SPLITS = [int(v) for v in np.cumsum(IN_SIZES)[:-1]]
IN_W = int(sum(IN_SIZES))

kernel_name = "hybrid_gated_diffattn_swa_mem_macaron"


def rms_norm(x, g):
    xf = x.astype(jnp.float32)
    y = xf * lax.rsqrt(jnp.mean(xf * xf, axis=-1, keepdims=True) + EPS)
    return (y * g.astype(jnp.float32)).astype(x.dtype)


def swiglu(x, wi, wo):
    a, b = jnp.split(x @ wi, 2, axis=-1)
    return (jax.nn.silu(a) * b) @ wo


def alibi_slopes(n):
    return jnp.asarray([2.0 ** (-8.0 * (i + 1) / n) for i in range(n)], dtype=jnp.float32)


def diff_attention(q, k, v, lam, slopes):
    B, S, H = q.shape[0], q.shape[1], q.shape[2]
    nb = S // BLOCK
    qb = q.reshape(B, nb, BLOCK, H, 2, DIFF_DK).transpose(1, 0, 3, 4, 2, 5)
    kt = k.transpose(0, 2, 3, 1, 4)
    vt = v.transpose(0, 2, 1, 3)
    pos_k = jnp.arange(S)
    scale = DIFF_DK ** -0.5

    def one_block(args):
        qblk, n = args
        s = jnp.einsum('bhmqd,bhmkd->bhmqk', qblk, kt).astype(jnp.float32) * scale
        dist = n * BLOCK + jnp.arange(BLOCK)[:, None] - pos_k[None, :]
        logits = s - slopes[None, :, None, None, None] * dist.astype(jnp.float32)
        logits = jnp.where(dist >= 0, logits, NEG_INF)
        p = jax.nn.softmax(logits, axis=-1)
        pd = p[:, :, 0] - lam * p[:, :, 1]
        return jnp.einsum('bhqk,bhkd->bhqd', pd.astype(v.dtype), vt)

    out = lax.map(one_block, (qb, jnp.arange(nb)))
    return out.transpose(1, 0, 3, 2, 4).reshape(B, S, H, DIFF_DV)


def swa_attention(q, k, v, sinks, slopes):
    B, S = q.shape[0], q.shape[1]
    nb = S // BLOCK
    G = SWA_HEADS // SWA_KV_HEADS
    qb = q.reshape(B, nb, BLOCK, SWA_KV_HEADS, G, SWA_HD)
    kb = k.reshape(B, nb, BLOCK, SWA_KV_HEADS, SWA_HD)
    vb = v.reshape(B, nb, BLOCK, SWA_KV_HEADS, SWA_HD)

    def with_prev(t):
        prev = jnp.concatenate([jnp.zeros_like(t[:, :1]), t[:, :-1]], axis=1)
        return jnp.concatenate([prev, t], axis=2)

    kk, vv = with_prev(kb), with_prev(vb)
    s = jnp.einsum('bnqkgd,bnskd->bnkgqs', qb, kk).astype(jnp.float32) * (SWA_HD ** -0.5)
    qi = jnp.arange(BLOCK)
    sj = jnp.arange(2 * BLOCK)
    dist = qi[:, None] + BLOCK - sj[None, :]
    key_pos = jnp.arange(nb)[:, None] * BLOCK - BLOCK + sj[None, :]
    mask = ((dist >= 0) & (dist < WINDOW))[None] & (key_pos >= 0)[:, None, :]
    sl = slopes.reshape(SWA_KV_HEADS, G, 1, 1)
    logits = s - sl * dist.astype(jnp.float32)
    logits = jnp.where(mask[None, :, None, None], logits, NEG_INF)
    sink = jnp.broadcast_to(sinks.astype(jnp.float32).reshape(SWA_KV_HEADS, G, 1, 1),
                            logits.shape[:-1] + (1,))
    p = jax.nn.softmax(jnp.concatenate([logits, sink], axis=-1), axis=-1)[..., :-1]
    out = jnp.einsum('bnkgqs,bnskd->bnqkgd', p.astype(v.dtype), vv)
    return out.reshape(B, S, SWA_Q_W)


def memory_attention(q, mk, mv):
    B, S = q.shape[0], q.shape[1]
    s = jnp.einsum('bshd,bmhd->bhsm', q, mk).astype(jnp.float32) * (MEM_HD ** -0.5)
    p = jax.nn.softmax(s, axis=-1)
    out = jnp.einsum('bhsm,bmhd->bshd', p.astype(mv.dtype), mv)
    return out.reshape(B, S, MEM_Q_W)


def setup_inputs(seed: int = 0) -> dict:
    key = jax.random.key(seed)
    ks = jax.random.split(key, 24)
    L, D, F = DEPTH, D_MODEL, D_FF

    def w(k, shape, fan_in):
        return jax.random.normal(k, shape, jnp.float32) * (fan_in ** -0.5)

    def gain(k, shape):
        return 1.0 + 0.01 * jax.random.normal(k, shape, jnp.float32)

    return {
        "x": jax.random.normal(ks[0], (BATCH, SEQ, D), jnp.float32),
        "mem": jax.random.normal(ks[1], (BATCH, MEM_LEN, D), jnp.float32),
        "ffn1_norm": gain(ks[2], (L, D)),
        "ffn1_wi": w(ks[3], (L, D, 2 * F), D),
        "ffn1_wo": w(ks[4], (L, F, D), F),
        "mix_norm": gain(ks[5], (L, D)),
        "w_in": w(ks[6], (L, D, IN_W), D),
        "diff_lambda": 0.1 * jax.random.normal(ks[7], (L, 4, DIFF_DK), jnp.float32),
        "diff_subnorm": gain(ks[8], (L, DIFF_DV)),
        "swa_sinks": 0.5 * jax.random.normal(ks[9], (L, SWA_HEADS), jnp.float32),
        "mem_norm": gain(ks[10], (L, D)),
        "w_mem_kv": w(ks[11], (L, D, 2 * MEM_Q_W), D),
        "w_br_diff": w(ks[12], (L, DIFF_V_W, D), DIFF_V_W),
        "w_br_swa": w(ks[13], (L, SWA_Q_W, D), SWA_Q_W),
        "w_br_mem": w(ks[14], (L, MEM_Q_W, D), MEM_Q_W),
        "w_out": w(ks[15], (L, D, D), D),
        "ffn2_norm": gain(ks[16], (L, D)),
        "ffn2_wi": w(ks[17], (L, D, 2 * F), D),
        "ffn2_wo": w(ks[18], (L, F, D), F),
        "final_norm": gain(ks[19], (D,)),
    }


def reference(x, mem, ffn1_norm, ffn1_wi, ffn1_wo, mix_norm, w_in, diff_lambda, diff_subnorm,
              swa_sinks, mem_norm, w_mem_kv, w_br_diff, w_br_swa, w_br_mem, w_out,
              ffn2_norm, ffn2_wi, ffn2_wo, final_norm):
    B, S = x.shape[0], x.shape[1]
    diff_slopes = alibi_slopes(DIFF_HEADS)
    swa_slopes = alibi_slopes(SWA_HEADS)
    for l in range(DEPTH):
        h = x + 0.5 * swiglu(rms_norm(x, ffn1_norm[l]), ffn1_wi[l], ffn1_wo[l])
        u = rms_norm(h, mix_norm[l])
        q_d, k_d, v_d, q_s, k_s, v_s, q_m, gates = jnp.split(u @ w_in[l], IN_SPLITS, axis=-1)
        lambda_init = 0.8 - 0.6 * math.exp(-0.3 * l)
        lp = diff_lambda[l].astype(jnp.float32)
        lam = jnp.exp(jnp.sum(lp[0] * lp[1])) - jnp.exp(jnp.sum(lp[2] * lp[3])) + lambda_init
        o_d = diff_attention(q_d.reshape(B, S, DIFF_HEADS, 2, DIFF_DK),
                             k_d.reshape(B, S, DIFF_HEADS, 2, DIFF_DK),
                             v_d.reshape(B, S, DIFF_HEADS, DIFF_DV), lam, diff_slopes)
        o_d = (rms_norm(o_d, diff_subnorm[l]) * (1.0 - lambda_init)).reshape(B, S, DIFF_V_W)
        o_s = swa_attention(q_s.reshape(B, S, SWA_HEADS, SWA_HD),
                            k_s.reshape(B, S, SWA_KV_HEADS, SWA_HD),
                            v_s.reshape(B, S, SWA_KV_HEADS, SWA_HD),
                            swa_sinks[l], swa_slopes)
        mk, mv = jnp.split(rms_norm(mem, mem_norm[l]) @ w_mem_kv[l], 2, axis=-1)
        M = mem.shape[1]
        o_m = memory_attention(q_m.reshape(B, S, MEM_HEADS, MEM_HD),
                               mk.reshape(B, M, MEM_HEADS, MEM_HD),
                               mv.reshape(B, M, MEM_HEADS, MEM_HD))
        g = jax.nn.sigmoid(gates).reshape(B, S, N_BRANCH, D_MODEL)
        merged = (g[:, :, 0] * (o_d @ w_br_diff[l])
                  + g[:, :, 1] * (o_s @ w_br_swa[l])
                  + g[:, :, 2] * (o_m @ w_br_mem[l]))
        h = h + merged @ w_out[l]
        x = h + 0.5 * swiglu(rms_norm(h, ffn2_norm[l]), ffn2_wi[l], ffn2_wo[l])
    return rms_norm(x, final_norm)
```

```cpp
#include <hip/hip_runtime.h>
#include <hip/hip_cooperative_groups.h>
#include <cstdio>
#include <cstdint>
namespace cg = cooperative_groups;

#ifndef MK_N_LAUNCHES
#define MK_N_LAUNCHES 1
#endif

#ifndef AB_MASK
#define AB_MASK 255
#endif
#ifndef PROBE_SUB
#define PROBE_SUB 6
#endif
#ifndef PROBE_K
#define PROBE_K 0
#endif
#define LAS __attribute__((address_space(3)))
typedef unsigned short bf16_t;
typedef short bf16x8 __attribute__((ext_vector_type(8)));
typedef short s16x4 __attribute__((ext_vector_type(4)));
typedef float f32x4 __attribute__((ext_vector_type(4)));
typedef float f32x16 __attribute__((ext_vector_type(16)));
typedef unsigned u32x4 __attribute__((ext_vector_type(4)));
typedef unsigned u32x2 __attribute__((ext_vector_type(2)));
typedef float f32x2_t __attribute__((ext_vector_type(2)));
typedef __bf16 bf16x2_t __attribute__((ext_vector_type(2)));

constexpr int BATCH = 8, SEQ = 4096, DM = 1024, FF = 2816, DEPTH = 2, MEMLEN = 256;
constexpr int M = BATCH * SEQ;
constexpr int MR = BATCH * MEMLEN;
constexpr int PW = 4352;
constexpr int C_QD = 0, C_KD = 1024, C_VD = 2048, C_QS = 3072, C_KS = 3584, C_VS = 3712, C_QM = 3840;
constexpr int INW = 7424;
constexpr float EPS = 1e-6f;
constexpr float LOG2E = 1.4426950408889634f;
constexpr float SQ64 = 0.125f * LOG2E;
constexpr float SQ128 = 0.08838834764831845f * LOG2E;

constexpr size_t MiB = 1u << 20;
constexpr size_t WS_W = 1 * MiB;
constexpr size_t W_FFN1I = WS_W + 0 * MiB, W_FFN1O = WS_W + 11 * MiB, W_IN = WS_W + 17 * MiB, W_G = WS_W + 26 * MiB, W_MKV = WS_W + 32 * MiB,
                 W_BRD = WS_W + 34 * MiB, W_BRS = WS_W + 36 * MiB, W_BRM = WS_W + 38 * MiB, W_OUT = WS_W + 40 * MiB, W_FFN2I = WS_W + 42 * MiB, W_FFN2O = WS_W + 53 * MiB;
constexpr size_t WS_XN = 60 * MiB;
constexpr size_t WS_MN = 124 * MiB;
constexpr size_t WS_MKV = 128 * MiB;
constexpr size_t WS_P = 132 * MiB;
constexpr size_t WS_MRG = 404 * MiB;
constexpr size_t WS_G = 468 * MiB;
constexpr size_t WS_SSQ = 500 * MiB;
constexpr size_t WS_END = 504 * MiB;

constexpr size_t WS_KNP = 32768;
constexpr int N_PHASES_K = 1 + 2 * 8 + 1;
constexpr int NWAVES = 8;
constexpr int LDS_BYTES = 147456;

__device__ __forceinline__ unsigned cvtpk(float lo, float hi) { f32x2_t v = {lo, hi}; bf16x2_t b = __builtin_convertvector(v, bf16x2_t); return __builtin_bit_cast(unsigned, b); }
__device__ __forceinline__ float bf_lo(unsigned w) { return __uint_as_float(w << 16); }
__device__ __forceinline__ float bf_hi(unsigned w) { return __uint_as_float(w & 0xffff0000u); }
__device__ __forceinline__ float ex2(float x) { return __builtin_amdgcn_exp2f(x); }
__device__ __forceinline__ float sigm(float x) { return __builtin_amdgcn_rcpf(1.f + ex2(-LOG2E * x)); }
__device__ __forceinline__ float rstd_of(const float* ssq4, int row) { if (!ssq4) return 1.f; const f32x4 p = *(const f32x4*)(ssq4 + (size_t)row * 4); return __builtin_amdgcn_rsqf(((p.x + p.y) + (p.z + p.w)) * (1.f / 1024.f) + 1e-6f); }
__device__ __forceinline__ float wave_sum(float v) {
#pragma unroll
    for (int o = 1; o < 64; o <<= 1) v += __shfl_xor(v, o);
    return v;
}

namespace pg8 {
constexpr int BM = 256, BK = 64, HALF = 128, HTB = HALF * BK * 2, STAGE_BYTES = 8 * HTB, NXCD = 8, WGM = 4;
__device__ __forceinline__ int lds_byte(int r, int c) { const int st = (r >> 4) * 2 + (c >> 5), rr = r & 15, cc = c & 31, ob = rr * 64 + cc * 2; return st * 1024 + (ob ^ (((ob >> 9) & 1) << 5)); }
__device__ __forceinline__ void stage_rc(int b, int& R, int& C) { const int st = b / 1024, sb = b % 1024, swz = sb ^ (((sb >> 9) & 1) << 5); R = (st >> 1) * 16 + swz / 64; C = (st & 1) * 32 + (swz % 64) / 2; }
__device__ __forceinline__ int perm32(int rho) { const int n = rho >> 4, i = rho & 15; return 8 * (i >> 2) + 4 * n + (i & 3); }

struct GUnit { const char* A; const char* B; unsigned lda, ldb; int nt; int pm, pn, kind; };

struct TileOrder {
    int nM, nN, nwg;
    __device__ __forceinline__ void init(int nM_, int nN_) { nM = nM_; nN = nN_; nwg = nM * nN; }
    __device__ __forceinline__ void tile(int L, int& pm, int& pn) const {
        int wgid = L; { const int q = nwg / NXCD, r = nwg % NXCD, xcd = wgid % NXCD, off = wgid / NXCD; wgid = (xcd < r ? xcd * (q + 1) : r * (q + 1) + (xcd - r) * q) + off; }
        const int nig = WGM * nN, gid = wgid / nig, fm = gid * WGM, gsz = (nM - fm) < WGM ? (nM - fm) : WGM;
        pm = fm + ((wgid % nig) % gsz); pn = (wgid % nig) / gsz;
    }
};

template <class Epi, class Sched>
__device__ __forceinline__ void gemm_phase(LAS unsigned char* lds, const Sched& S, const Epi& E, const int tid) {
    const int wid = __builtin_amdgcn_readfirstlane(tid >> 6), lane = tid & 63, wr = wid >> 2, wc = wid & 3, fr = lane & 15, fq = lane >> 4;
    int R0, C0; stage_rc(tid * 16, R0, C0);
    const int Rb0 = Epi::PERM ? ((R0 & ~31) + perm32(R0 & 31)) : R0;
    const size_t kstep = (size_t)(BK * 2);
    const unsigned ldsw = (unsigned)wid * 1024u;
    const int aoff = lds_byte(wr * 64 + fr, fq * 8), boff = lds_byte(wc * 32 + fr, fq * 8);
#define PG8_SA(b, h) (((b) * 2 + (h)) * HTB)
#define PG8_SB(b, h) ((4 + (b) * 2 + (h)) * HTB)
#define PG8_STAGE(bufoff, gbase, v0, q64) do { \
        __builtin_amdgcn_global_load_lds((const unsigned*)((const char*)(gbase) + (v0)), (LAS unsigned*)(lds + (bufoff) + ldsw), 16, 0, 0); \
        __builtin_amdgcn_global_load_lds((const unsigned*)((const char*)(gbase) + (q64) + (v0)), (LAS unsigned*)(lds + (bufoff) + ldsw + 8192), 16, 0, 0); } while (0)
#define PG8_LDA(dst, b, h) do { _Pragma("unroll") for (int m = 0; m < 4; ++m) _Pragma("unroll") for (int k = 0; k < 2; ++k) dst[m][k] = *(const LAS bf16x8*)(lds + PG8_SA(b, h) + aoff + m * 2048 + k * 1024); } while (0)
#define PG8_LDB(dst, b, h) do { _Pragma("unroll") for (int n = 0; n < 2; ++n) _Pragma("unroll") for (int k = 0; k < 2; ++k) dst[n][k] = *(const LAS bf16x8*)(lds + PG8_SB(b, h) + boff + n * 2048 + k * 1024); } while (0)
#define PG8_MMA(ai, bj, At, Bt) do { __builtin_amdgcn_s_setprio(1); _Pragma("unroll") for (int m = 0; m < 4; ++m) _Pragma("unroll") for (int n = 0; n < 2; ++n) _Pragma("unroll") for (int k = 0; k < 2; ++k) \
        acc[ai][bj][m][n] = __builtin_amdgcn_mfma_f32_16x16x32_bf16(Bt[n][k], At[m][k], acc[ai][bj][m][n], 0, 0, 0); __builtin_amdgcn_s_setprio(0); } while (0)
#define PG8_WAIT_V(n) asm volatile("s_waitcnt vmcnt(" #n ")" ::: "memory")
#define PG8_WAIT_L(n) asm volatile("s_waitcnt lgkmcnt(" #n ")" ::: "memory")
#define PG8_BAR __builtin_amdgcn_s_barrier()
#define PG8_SCHED __builtin_amdgcn_sched_barrier(0)
    GUnit cur, nxt; int ui = 0;
    if (!S.next(0, cur)) return;
    f32x4 acc[2][2][4][2];
#pragma unroll
    for (int a = 0; a < 2; ++a)
#pragma unroll
        for (int b = 0; b < 2; ++b)
#pragma unroll
            for (int m = 0; m < 4; ++m)
#pragma unroll
                for (int n = 0; n < 2; ++n) acc[a][b][m][n] = (f32x4){0.f, 0.f, 0.f, 0.f};
    bf16x8 At[4][2], B0[2][2], B1[2][2];
    const char* cA = cur.A; const char* cB = cur.B;
    unsigned vAc = (unsigned)R0 * cur.lda + (unsigned)C0 * 2u, vBc = (unsigned)Rb0 * cur.ldb + (unsigned)C0 * 2u;
    size_t hAc = (size_t)HALF * cur.lda, hBc = (size_t)HALF * cur.ldb;
    PG8_STAGE(PG8_SB(0, 0), cB, vBc, hBc / 2); PG8_STAGE(PG8_SB(0, 1), cB + hBc, vBc, hBc / 2); PG8_STAGE(PG8_SA(0, 0), cA, vAc, hAc / 2); PG8_STAGE(PG8_SA(0, 1), cA + hAc, vAc, hAc / 2);
    if (wr == 1) PG8_BAR;
    PG8_WAIT_V(2); PG8_BAR;
    PG8_STAGE(PG8_SB(1, 0), cB + kstep, vBc, hBc / 2); PG8_STAGE(PG8_SA(1, 0), cA + kstep, vAc, hAc / 2); PG8_STAGE(PG8_SB(1, 1), cB + hBc + kstep, vBc, hBc / 2);
    PG8_WAIT_V(6); PG8_BAR;
    for (;;) {
        const bool has_next = S.next(ui + 1, nxt);
        if (!has_next) nxt = cur;
        const char* nA = nxt.A; const char* nB = nxt.B;
        unsigned vAn = vAc, vBn = vBc;
        if (Sched::VARLDA) vAn = (unsigned)R0 * nxt.lda + (unsigned)C0 * 2u;
        if (Sched::VARLDB) vBn = (unsigned)Rb0 * nxt.ldb + (unsigned)C0 * 2u;
        const size_t hAn = (size_t)HALF * nxt.lda, hBn = (size_t)HALF * nxt.ldb;
        const int nt = cur.nt;
        for (int t = 0; t < nt; t += 2) {
            const bool last = (t == nt - 2);
            const char* a1 = cA + (size_t)(t + 1) * kstep;
            const char* a2 = last ? nA : cA + (size_t)(t + 2) * kstep; const char* b2 = last ? nB : cB + (size_t)(t + 2) * kstep;
            const char* a3 = a2 + kstep; const char* b3 = b2 + kstep;
            const unsigned vA = (Sched::VARLDA && last) ? vAn : vAc, vB = (Sched::VARLDB && last) ? vBn : vBc;
            const size_t hA = last ? hAn : hAc, hB = last ? hBn : hBc;
            PG8_LDB(B0, 0, 0); PG8_LDB(B1, 0, 1); PG8_SCHED; PG8_LDA(At, 0, 0); PG8_STAGE(PG8_SA(1, 1), a1 + hAc, vAc, hAc / 2);
            PG8_WAIT_V(8); PG8_WAIT_L(0); PG8_BAR; PG8_MMA(0, 0, At, B0); PG8_MMA(0, 1, At, B1); PG8_BAR; PG8_SCHED;
            PG8_LDA(At, 0, 1); PG8_STAGE(PG8_SB(0, 0), b2, vB, hB / 2); PG8_STAGE(PG8_SB(0, 1), b2 + hB, vB, hB / 2); PG8_STAGE(PG8_SA(0, 0), a2, vA, hA / 2);
            PG8_WAIT_V(8); PG8_WAIT_L(0); PG8_BAR; PG8_MMA(1, 0, At, B0); PG8_MMA(1, 1, At, B1); PG8_BAR; PG8_SCHED;
            PG8_LDB(B0, 1, 0); PG8_LDB(B1, 1, 1); PG8_SCHED; PG8_LDA(At, 1, 0); PG8_STAGE(PG8_SA(0, 1), a2 + hA, vA, hA / 2);
            PG8_WAIT_V(8); PG8_WAIT_L(0); PG8_BAR; PG8_MMA(0, 0, At, B0); PG8_MMA(0, 1, At, B1); PG8_BAR; PG8_SCHED;
            PG8_LDA(At, 1, 1); PG8_STAGE(PG8_SB(1, 0), b3, vB, hB / 2); PG8_STAGE(PG8_SB(1, 1), b3 + hB, vB, hB / 2); PG8_STAGE(PG8_SA(1, 0), a3, vA, hA / 2);
            PG8_WAIT_V(8); PG8_WAIT_L(0); PG8_BAR; PG8_MMA(1, 0, At, B0); PG8_MMA(1, 1, At, B1); PG8_BAR; PG8_SCHED;
        }
        if (Epi::ALIGN) { if (wr == 0) PG8_BAR; }
        E(acc, cur, wr, wc, fr, fq, tid, lds);
        if (!has_next) break;
#pragma unroll
        for (int a = 0; a < 2; ++a)
#pragma unroll
            for (int b = 0; b < 2; ++b)
#pragma unroll
                for (int m = 0; m < 4; ++m)
#pragma unroll
                    for (int n = 0; n < 2; ++n) acc[a][b][m][n] = (f32x4){0.f, 0.f, 0.f, 0.f};
        cur = nxt; cA = nA; cB = nB; vAc = vAn; vBc = vBn; hAc = hAn; hBc = hBn; ++ui;
        if (Epi::ALIGN) { if (wr == 1) PG8_BAR; }
    }
    PG8_WAIT_V(0);
    if (!Epi::ALIGN) { if (wr == 0) PG8_BAR; }
    PG8_BAR;
#undef PG8_SA
#undef PG8_SB
#undef PG8_STAGE
#undef PG8_LDA
#undef PG8_LDB
#undef PG8_MMA
#undef PG8_WAIT_V
#undef PG8_WAIT_L
#undef PG8_BAR
#undef PG8_SCHED
}

struct EpiSwiglu {
    static constexpr bool PERM = true, ALIGN = false;
    bf16_t* O; const float* ssq;
    __device__ __forceinline__ void operator()(const f32x4 (&acc)[2][2][4][2], const GUnit& u, int wr, int wc, int fr, int fq, int tid, LAS unsigned char* lds) const {
        const int row0 = u.pm * BM + wr * 64 + fr, col0 = u.pn * 128 + wc * 32 + 8 * fq;
#pragma unroll
        for (int ai = 0; ai < 2; ++ai)
#pragma unroll
            for (int m = 0; m < 4; ++m) {
                bf16_t* rowp = O + (size_t)(row0 + ai * HALF + m * 16) * FF + col0;
                const float rs = rstd_of(ssq, row0 + ai * HALF + m * 16);
                float v[8];
#pragma unroll
                for (int n = 0; n < 2; ++n)
#pragma unroll
                    for (int j = 0; j < 4; ++j) { const float a = acc[ai][0][m][n][j] * rs, b = acc[ai][1][m][n][j] * rs; v[n * 4 + j] = a * sigm(a) * b; }
                u32x4 w; w.x = cvtpk(v[0], v[1]); w.y = cvtpk(v[2], v[3]); w.z = cvtpk(v[4], v[5]); w.w = cvtpk(v[6], v[7]);
                *(u32x4*)rowp = w;
            }
    }
};
struct EpiResidual {
    static constexpr bool PERM = true, ALIGN = true;
    const float* base32; const bf16_t* base16; bf16_t* out16; float* ssq; int mode;
    __device__ __forceinline__ void operator()(const f32x4 (&acc)[2][2][4][2], const GUnit& u, int wr, int wc, int fr, int fq, int tid, LAS unsigned char* lds) const {
        const float s = (mode == 0) ? 0.f : (mode == 1) ? 0.5f : 1.f;
        const int col0 = u.pn * BM + wc * 32 + 8 * fq;
        LAS float* Pl = (LAS float*)(lds + STAGE_BYTES);
        float qs[2][4];
#pragma unroll
        for (int ai = 0; ai < 2; ++ai) {
#pragma unroll
            for (int m = 0; m < 4; ++m) qs[ai][m] = 0.f;
            if (base32) {
                f32x4 bs[4][2][2];
#pragma unroll
                for (int m = 0; m < 4; ++m) { const size_t off = (size_t)(u.pm * BM + ai * HALF + wr * 64 + m * 16 + fr) * DM + col0;
#pragma unroll
                    for (int bj = 0; bj < 2; ++bj)
#pragma unroll
                        for (int n = 0; n < 2; ++n) bs[m][bj][n] = *(const f32x4*)(base32 + off + bj * HALF + n * 4); }
                asm volatile("" ::: "memory");
#pragma unroll
                for (int m = 0; m < 4; ++m) { const size_t off = (size_t)(u.pm * BM + ai * HALF + wr * 64 + m * 16 + fr) * DM + col0;
#pragma unroll
                    for (int bj = 0; bj < 2; ++bj) { const f32x4 v0 = bs[m][bj][0] + acc[ai][bj][m][0] * s, v1 = bs[m][bj][1] + acc[ai][bj][m][1] * s;
                        u32x4 w; w.x = cvtpk(v0[0], v0[1]); w.y = cvtpk(v0[2], v0[3]); w.z = cvtpk(v1[0], v1[1]); w.w = cvtpk(v1[2], v1[3]);
                        qs[ai][m] += ((v0[0] * v0[0] + v0[1] * v0[1]) + (v0[2] * v0[2] + v0[3] * v0[3])) + ((v1[0] * v1[0] + v1[1] * v1[1]) + (v1[2] * v1[2] + v1[3] * v1[3]));
                        *(u32x4*)(out16 + off + bj * HALF) = w; } }
            } else {
                u32x4 bs[4][2];
#pragma unroll
                for (int m = 0; m < 4; ++m) { const size_t off = (size_t)(u.pm * BM + ai * HALF + wr * 64 + m * 16 + fr) * DM + col0;
#pragma unroll
                    for (int bj = 0; bj < 2; ++bj) bs[m][bj] = *(const u32x4*)(base16 + off + bj * HALF); }
                asm volatile("" ::: "memory");
#pragma unroll
                for (int m = 0; m < 4; ++m) { const size_t off = (size_t)(u.pm * BM + ai * HALF + wr * 64 + m * 16 + fr) * DM + col0;
#pragma unroll
                    for (int bj = 0; bj < 2; ++bj) { const u32x4 b = bs[m][bj]; const f32x4 a0 = acc[ai][bj][m][0] * s, a1 = acc[ai][bj][m][1] * s;
                        const f32x4 v0 = (f32x4){bf_lo(b.x) + a0[0], bf_hi(b.x) + a0[1], bf_lo(b.y) + a0[2], bf_hi(b.y) + a0[3]}, v1 = (f32x4){bf_lo(b.z) + a1[0], bf_hi(b.z) + a1[1], bf_lo(b.w) + a1[2], bf_hi(b.w) + a1[3]};
                        u32x4 w; w.x = cvtpk(v0[0], v0[1]); w.y = cvtpk(v0[2], v0[3]); w.z = cvtpk(v1[0], v1[1]); w.w = cvtpk(v1[2], v1[3]);
                        qs[ai][m] += ((v0[0] * v0[0] + v0[1] * v0[1]) + (v0[2] * v0[2] + v0[3] * v0[3])) + ((v1[0] * v1[0] + v1[1] * v1[1]) + (v1[2] * v1[2] + v1[3] * v1[3]));
                        *(u32x4*)(out16 + off + bj * HALF) = w; } }
            }
            asm volatile("" ::: "memory");
        }
#pragma unroll
        for (int ai = 0; ai < 2; ++ai)
#pragma unroll
            for (int m = 0; m < 4; ++m) { float q = qs[ai][m]; q += __shfl_xor(q, 16); q += __shfl_xor(q, 32);
                if (fq == 0) Pl[(ai * HALF + wr * 64 + m * 16 + fr) * 4 + wc] = q; }
        asm volatile("s_waitcnt lgkmcnt(0)" ::: "memory"); __builtin_amdgcn_s_barrier(); asm volatile("" ::: "memory");
        if (tid < 256) { const f32x4 p = *(const LAS f32x4*)(Pl + tid * 4); ssq[(size_t)(u.pm * BM + tid) * 4 + u.pn] = (p.x + p.y) + (p.z + p.w); }
        asm volatile("s_waitcnt lgkmcnt(0)" ::: "memory"); __builtin_amdgcn_s_barrier(); asm volatile("" ::: "memory");
    }
};
struct EpiProj {
    static constexpr bool PERM = true, ALIGN = false;
    bf16_t* P; bf16_t* MKV; unsigned* KNP; const float* ssq;
    __device__ __forceinline__ void operator()(const f32x4 (&acc)[2][2][4][2], const GUnit& u, int wr, int wc, int fr, int fq, int tid, LAS unsigned char* lds) const {
        float sc = 1.f; bf16_t* base; size_t ld;
        if (u.kind == 0) { base = P; ld = PW; const int pn = u.pn; if (pn < 4 || pn == 12 || pn == 13) sc = SQ64; else if (pn == 15 || pn == 16) sc = SQ128; }
        else { base = MKV; ld = DM; }
        const int row0 = u.pm * BM + wr * 64 + fr, col0 = u.pn * BM + wc * 32 + 8 * fq;
        float mx0 = 0.f, mx1 = 0.f;
#pragma unroll
        for (int ai = 0; ai < 2; ++ai)
#pragma unroll
            for (int m = 0; m < 4; ++m) {
                bf16_t* rowp = base + (size_t)(row0 + ai * HALF + m * 16) * ld + col0;
                const float scr = (u.kind == 0) ? sc * rstd_of(ssq, row0 + ai * HALF + m * 16) : sc;
#pragma unroll
                for (int bj = 0; bj < 2; ++bj) { const f32x4 v0 = acc[ai][bj][m][0] * scr, v1 = acc[ai][bj][m][1] * scr;
                    u32x4 w; w.x = cvtpk(v0[0], v0[1]); w.y = cvtpk(v0[2], v0[3]); w.z = cvtpk(v1[0], v1[1]); w.w = cvtpk(v1[2], v1[3]);
                    *(u32x4*)(rowp + bj * HALF) = w;
                    float q = ((v0[0] * v0[0] + v0[1] * v0[1]) + (v0[2] * v0[2] + v0[3] * v0[3])) + ((v1[0] * v1[0] + v1[1] * v1[1]) + (v1[2] * v1[2] + v1[3] * v1[3]));
                    q += __shfl_xor(q, 16); q += __shfl_xor(q, 32);
                    if (bj == 0) mx0 = fmaxf(mx0, q); else mx1 = fmaxf(mx1, q); }
            }
        if (u.kind == 0 && u.pn >= 4 && u.pn < 8) {
#pragma unroll
            for (int o = 1; o < 16; o <<= 1) { mx0 = fmaxf(mx0, __shfl_xor(mx0, o)); mx1 = fmaxf(mx1, __shfl_xor(mx1, o)); }
            if ((tid & 63) == 0) { const int b = u.pm >> 4, h0 = (u.pn - 4) * 2;
                __hip_atomic_fetch_max(KNP + ((b * 8 + h0) * 2 + (wc >> 1)) * 2 + (wc & 1), __float_as_uint(mx0), __ATOMIC_RELAXED, __HIP_MEMORY_SCOPE_AGENT);
                __hip_atomic_fetch_max(KNP + ((b * 8 + h0 + 1) * 2 + (wc >> 1)) * 2 + (wc & 1), __float_as_uint(mx1), __ATOMIC_RELAXED, __HIP_MEMORY_SCOPE_AGENT); }
        }
    }
};
struct EpiBranch {
    static constexpr bool PERM = true, ALIGN = true;
    u32x4* G;
    bf16_t* MRG;
    const float* ssq;
    u32x4* PS;
    __device__ __forceinline__ void operator()(const f32x4 (&acc)[2][2][4][2], const GUnit& u, int wr, int wc, int fr, int fq, int tid, LAS unsigned char* lds) const {
        const int row0 = u.pm * BM + wr * 64 + fr, col0 = u.pn * BM + wc * 32 + 8 * fq;
        const __amdgpu_buffer_rsrc_t grs = __builtin_amdgcn_make_buffer_rsrc((void*)G, (short)0, 131072, 0x00020000);
        const __amdgpu_buffer_rsrc_t prs = __builtin_amdgcn_make_buffer_rsrc((void*)PS, (short)0, 131072, 0x00020000);
        if ((u.kind & 1) == 0) {
#pragma unroll
            for (int ai = 0; ai < 2; ++ai)
#pragma unroll
                for (int bj = 0; bj < 2; ++bj)
#pragma unroll
                    for (int m = 0; m < 4; ++m) { const float rs = rstd_of(ssq, row0 + ai * HALF + m * 16); const f32x4 a = acc[ai][bj][m][0] * rs, b = acc[ai][bj][m][1] * rs;
                        u32x4 w; w.x = cvtpk(sigm(a[0]), sigm(a[1])); w.y = cvtpk(sigm(a[2]), sigm(a[3])); w.z = cvtpk(sigm(b[0]), sigm(b[1])); w.w = cvtpk(sigm(b[2]), sigm(b[3]));
                        __builtin_amdgcn_raw_buffer_store_b128(w, grs, tid * 16, ((ai * 2 + bj) * 4 + m) * 8192, 0); }
        } else {
            const bool addp = u.kind > 1;
#pragma unroll
            for (int ai = 0; ai < 2; ++ai) {
                u32x4 g[2][4], o[2][4];
#pragma unroll
                for (int bj = 0; bj < 2; ++bj)
#pragma unroll
                    for (int m = 0; m < 4; ++m) { g[bj][m] = __builtin_amdgcn_raw_buffer_load_b128(grs, tid * 16, ((ai * 2 + bj) * 4 + m) * 8192, 0);
                        o[bj][m] = addp ? __builtin_amdgcn_raw_buffer_load_b128(prs, tid * 16, ((ai * 2 + bj) * 4 + m) * 8192, 0) : (u32x4){0u, 0u, 0u, 0u}; }
                asm volatile("" ::: "memory");
#pragma unroll
                for (int bj = 0; bj < 2; ++bj)
#pragma unroll
                    for (int m = 0; m < 4; ++m) {
                        bf16_t* p = MRG + (size_t)(row0 + ai * HALF + m * 16) * DM + col0 + bj * HALF;
                        const f32x4 a = acc[ai][bj][m][0], b = acc[ai][bj][m][1]; const u32x4 gg = g[bj][m], oo = o[bj][m];
                        float v[8] = {a[0] * bf_lo(gg.x), a[1] * bf_hi(gg.x), a[2] * bf_lo(gg.y), a[3] * bf_hi(gg.y), b[0] * bf_lo(gg.z), b[1] * bf_hi(gg.z), b[2] * bf_lo(gg.w), b[3] * bf_hi(gg.w)};
                        v[0] += bf_lo(oo.x); v[1] += bf_hi(oo.x); v[2] += bf_lo(oo.y); v[3] += bf_hi(oo.y); v[4] += bf_lo(oo.z); v[5] += bf_hi(oo.z); v[6] += bf_lo(oo.w); v[7] += bf_hi(oo.w);
                        u32x4 w; w.x = cvtpk(v[0], v[1]); w.y = cvtpk(v[2], v[3]); w.z = cvtpk(v[4], v[5]); w.w = cvtpk(v[6], v[7]);
                        if (u.kind == 5) *(u32x4*)p = w; else __builtin_amdgcn_raw_buffer_store_b128(w, prs, tid * 16, ((ai * 2 + bj) * 4 + m) * 8192, 0);
                    }
                asm volatile("" ::: "memory");
            }
        }
    }
};

struct SchedSimple {
    static constexpr bool VARLDA = false, VARLDB = false;
    TileOrder T; int G, c; const char* A; const char* B; unsigned lda, ldb; int nt;
    __device__ __forceinline__ bool next(int i, GUnit& u) const {
        const int L = i * G + c; if (L >= T.nwg) return false;
        int pm, pn; T.tile(L, pm, pn);
        u.A = A + (size_t)pm * BM * lda; u.B = B + (size_t)pn * BM * ldb; u.lda = lda; u.ldb = ldb; u.nt = nt; u.pm = pm; u.pn = pn; u.kind = 0; return true;
    }
};
struct SchedProj {
    static constexpr bool VARLDA = false, VARLDB = false;
    TileOrder T; int G, c; const char* XN; const char* WIN; const char* MN; const char* WMKV;
    __device__ __forceinline__ bool next(int i, GUnit& u) const {
        const int L = i * G + c;
        if (L < T.nwg) { int pm, pn; T.tile(L, pm, pn); u.A = XN + (size_t)pm * BM * 2048; u.B = WIN + (size_t)pn * BM * 2048; u.pm = pm; u.pn = pn; u.kind = 0; }
        else { const int r = L - T.nwg; if (r >= 32) return false; const int pm = r >> 2, pn = r & 3; u.A = MN + (size_t)pm * BM * 2048; u.B = WMKV + (size_t)pn * BM * 2048; u.pm = pm; u.pn = pn; u.kind = 1; }
        u.lda = 2048; u.ldb = 2048; u.nt = 16; return true;
    }
};
struct SchedBranch {
    static constexpr bool VARLDA = true, VARLDB = false;
    TileOrder T; int G, c; const char* XN; const char* P; const char* WG; const char* WBD; const char* WBS; const char* WBM;
    __device__ __forceinline__ bool next(int i, GUnit& u) const {
        const int pair = i / 6, sub = i - pair * 6; const int L = pair * G + c; if (L >= T.nwg) return false;
        int pm, pn; T.tile(L, pm, pn); u.pm = pm; u.pn = pn; u.kind = sub;
        if ((sub & 1) == 0) { u.A = XN + (size_t)pm * BM * 2048; u.lda = 2048; u.B = WG + (size_t)((sub >> 1) * 1024 + pn * BM) * 2048; u.ldb = 2048; u.nt = 16; }
        else if (sub == 1) { u.A = P + (size_t)pm * BM * (PW * 2) + C_QD * 2; u.lda = PW * 2; u.B = WBD + (size_t)pn * BM * 2048; u.ldb = 2048; u.nt = 16; }
        else if (sub == 3) { u.A = P + (size_t)pm * BM * (PW * 2) + C_QS * 2; u.lda = PW * 2; u.B = WBS + (size_t)pn * BM * 2048; u.ldb = 2048; u.nt = 8; }
        else { u.A = P + (size_t)pm * BM * (PW * 2) + C_QM * 2; u.lda = PW * 2; u.B = WBM + (size_t)pn * BM * 2048; u.ldb = 2048; u.nt = 8; }
        return true;
    }
};
}

namespace fa {
__device__ __forceinline__ int crow(int r, int hi) { return (r & 3) + 8 * (r >> 2) + 4 * hi; }
__device__ __forceinline__ float swap_max(float m) { auto rr = __builtin_amdgcn_permlane32_swap(__float_as_uint(m), __float_as_uint(m), false, false); return fmaxf(__uint_as_float(rr[0]), __uint_as_float(rr[1])); }
__device__ __forceinline__ float swap_add(float m) { auto rr = __builtin_amdgcn_permlane32_swap(__float_as_uint(m), __float_as_uint(m), false, false); return __uint_as_float(rr[0]) + __uint_as_float(rr[1]); }
typedef short v4i16_t __attribute__((ext_vector_type(4)));
__device__ __forceinline__ s16x4 vtr(const LAS char* p) { return __builtin_bit_cast(s16x4, __builtin_amdgcn_ds_read_tr16_b64_v4i16((LAS v4i16_t*)p)); }

constexpr int L_SLOT = 32768  , L_XCH = 0, L_WSF = 131072, L_FLG = 133120;
static_assert(4 * 128 * 33 * 4 <= L_WSF && 4 * L_SLOT <= L_WSF && L_WSF + 8 * 256 <= L_FLG && L_FLG + 64 <= LDS_BYTES - 64, "attention LDS map");

template <int DQK, int DV, int KW, int MODE>
__device__ __forceinline__ void flash_core(LAS char* lds, const bf16_t* Qw, int qpitch, const bf16_t* Kg, int kpitch, const bf16_t* Vg, int vpitch,
                                           int kstart, int t0, int nt, int koff, int qpos, float slope2, float m_init, float l_init, f32x16 (&o)[DV / 32], const int tid, const float kn = 0.f) {
    const int lane = tid & 63, r32 = lane & 31, hi = lane >> 5; const int wid = __builtin_amdgcn_readfirstlane(tid >> 6);
    constexpr int NKS = DQK / 16, NDB = DV / 32, KCH = KW / 8, VCH = DV / 8;
    constexpr int KPT = 64 * KCH / 512, VPT = 64 * VCH / 512;
    LAS float* wsf = (LAS float*)(lds + L_WSF) + wid * 64;
    bf16x8 qr[NKS];
#pragma unroll
    for (int ks = 0; ks < NKS; ++ks) qr[ks] = *(const bf16x8*)(Qw + (size_t)r32 * qpitch + ks * 16 + hi * 8);
    float qn = 0.f;
    if (MODE == 0) {
#pragma unroll
        for (int ks = 0; ks < NKS; ++ks)
#pragma unroll
            for (int j = 0; j < 8; ++j) { const float v = __uint_as_float(((unsigned)(unsigned short)qr[ks][j]) << 16); qn += v * v; }
        qn = sqrtf(swap_add(qn)) * kn;
    }
    LAS unsigned* xfl = (LAS unsigned*)(lds + L_FLG);
    const int ksw = (KW == 128) ? (r32 & 15) : ((r32 >> 1) & 7);
    int kad[NKS];
#pragma unroll
    for (int ks = 0; ks < NKS; ++ks) kad[ks] = r32 * (KW * 2) + ((((koff >> 3) + 2 * ks + hi) ^ ksw) << 4);
    const int vad = ((lane >> 4) & 1) * 32 + (lane & 3) * 8 + (4 * hi + ((lane & 15) >> 2)) * 64;
    constexpr int KPW = (64 * KW * 2 / 1024) / 8, VPW = (64 * DV * 2 / 1024) / 8;
    static_assert(KPW >= 1 && KPW <= 2 && VPW >= 1 && VPW <= 2, "pieces");
    unsigned kgoff[KPW], vgoff[VPW];
#pragma unroll
    for (int i = 0; i < KPW; ++i) { const int p = wid + 8 * i; const int row = (KW == 128) ? (4 * p + (lane >> 4)) : (8 * p + (lane >> 3)); const int slot = (KW == 128) ? (lane & 15) : (lane & 7);
        const int ch = slot ^ ((KW == 128) ? (row & 15) : ((row >> 1) & 7)); kgoff[i] = (unsigned)(row * kpitch + ch * 8) * 2u; }
#pragma unroll
    for (int i = 0; i < VPW; ++i) { const int q = wid + 8 * i; const int db = q >> 2, rg = q & 3; vgoff[i] = (unsigned)((rg * 16 + (lane >> 2)) * vpitch + db * 32 + (lane & 3) * 8) * 2u; }
#define FA_DMA(t, slot_) do { const long rb_ = (long)kstart + 64L * (t); const char* kb_ = (const char*)(Kg + rb_ * (long)kpitch); const char* vb_ = (const char*)(Vg + rb_ * (long)vpitch); \
        _Pragma("unroll") for (int i = 0; i < KPW; ++i) __builtin_amdgcn_global_load_lds((const unsigned*)(kb_ + kgoff[i]), (LAS unsigned*)(lds + (slot_) * L_SLOT + (wid + 8 * i) * 1024), 16, 0, 0); \
        _Pragma("unroll") for (int i = 0; i < VPW; ++i) __builtin_amdgcn_global_load_lds((const unsigned*)(vb_ + vgoff[i]), (LAS unsigned*)(lds + (slot_) * L_SLOT + 16384 + (wid + 8 * i) * 1024), 16, 0, 0); } while (0)
    float m = m_init, l = (hi == 0) ? l_init : 0.f;
    constexpr float THR = 8.f, SKIPT = 25.f;
    bf16x8 ke0, ke1; unsigned spk;
    { const unsigned one2 = 0x3f803f80u;
      const unsigned j0 = cvtpk((float)r32, (float)r32), j1 = cvtpk((float)(r32 + 32), (float)(r32 + 32));
      const u32x4 a0_ = (hi == 0) ? (u32x4){j0, one2, 0u, 0u} : (u32x4){0u, 0u, 0u, 0u};
      const u32x4 a1_ = (hi == 0) ? (u32x4){j1, one2, 0u, 0u} : (u32x4){0u, 0u, 0u, 0u};
      ke0 = __builtin_bit_cast(bf16x8, a0_); ke1 = __builtin_bit_cast(bf16x8, a1_);
      const float sl = (MODE != 2) ? slope2 : 0.f; const unsigned sh = cvtpk(sl, 0.f) & 0xffffu; const float shf = __uint_as_float(sh << 16);
      spk = (hi == 0) ? (sh | (cvtpk(sl - shf, 0.f) << 16)) : 0u; }
    bool mset = (m_init > -1e29f);
    if (!mset) m = 0.f;
#pragma unroll
    for (int d = 0; d < NDB; ++d)
#pragma unroll
        for (int r = 0; r < 16; ++r) o[d][r] = 0.f;
    constexpr int TPB = (MODE == 2) ? 1 : 2;
    const int nit = nt - t0;
    const int tfirst = (MODE == 0) ? (nt - 1) : t0, tstep = (MODE == 0) ? -1 : 1;
#pragma unroll
    for (int u = 0; u < TPB; ++u) if (u < nit) FA_DMA(tfirst + tstep * u, u);
    asm volatile("s_waitcnt vmcnt(0)" ::: "memory");
    __syncthreads();
    int cur = 0;
    for (int ib = 0; ib * TPB < nit; ++ib) {
#pragma unroll
        for (int u = 0; u < TPB; ++u) { const int itn = (ib + 1) * TPB + u; if (itn < nit) { if (cur) FA_DMA(tfirst + tstep * itn, u); else FA_DMA(tfirst + tstep * itn, TPB + u); } }
        const int tn = tfirst + tstep * ((ib + 1) * TPB);
#pragma unroll
        for (int u = 0; u < TPB; ++u) {
        const int it = ib * TPB + u;
        if (it < nit) {
        const int t = tfirst + tstep * it;
        const int kb = (cur ? TPB + u : u) * L_SLOT, vb = kb + 16384;
        f32x16 p0, p1;
        { const float dref = ((MODE != 2) ? slope2 * (float)(kstart + 64 * t - qpos) : 0.f) - m;
          const unsigned dh = cvtpk(dref, 0.f) & 0xffffu; const float dhf = __uint_as_float(dh << 16);
          const unsigned dpk = (hi == 0) ? (dh | (cvtpk(dref - dhf, 0.f) << 16)) : 0u;
          const u32x4 qe_ = (u32x4){spk, dpk, 0u, 0u}; const bf16x8 qe = __builtin_bit_cast(bf16x8, qe_);
          f32x16 z;
#pragma unroll
          for (int r = 0; r < 16; ++r) z[r] = 0.f;
          p0 = __builtin_amdgcn_mfma_f32_32x32x16_bf16(ke0, qe, z, 0, 0, 0);
          p1 = __builtin_amdgcn_mfma_f32_32x32x16_bf16(ke1, qe, z, 0, 0, 0); }
        { bf16x8 an0 = *(const LAS bf16x8*)(lds + kb + kad[0]), an1 = *(const LAS bf16x8*)(lds + kb + kad[0] + 32 * KW * 2);
#pragma unroll
          for (int ks = 0; ks < NKS; ++ks) {
            const bf16x8 a0 = an0, a1 = an1;
            if (ks + 1 < NKS) { an0 = *(const LAS bf16x8*)(lds + kb + kad[ks + 1 < NKS ? ks + 1 : 0]); an1 = *(const LAS bf16x8*)(lds + kb + kad[ks + 1 < NKS ? ks + 1 : 0] + 32 * KW * 2); }
            __builtin_amdgcn_sched_barrier(0);
            p0 = __builtin_amdgcn_mfma_f32_32x32x16_bf16(a0, qr[ks], p0, 0, 0, 0);
            p1 = __builtin_amdgcn_mfma_f32_32x32x16_bf16(a1, qr[ks], p1, 0, 0, 0);
            __builtin_amdgcn_sched_barrier(0);
          } }
        if (MODE != 2) {
            if (MODE == 1 || t >= nt - 2) {
                const int dq = qpos - (kstart + 64 * t + 4 * hi);
#pragma unroll
                for (int r = 0; r < 16; ++r) { const int c = (r & 3) + 8 * (r >> 2); const int d0 = dq - c, d1 = dq - c - 32;
                    const bool ok0 = (MODE == 1) ? (d0 >= 0 && d0 < 128) : (d0 >= 0), ok1 = (MODE == 1) ? (d1 >= 0 && d1 < 128) : (d1 >= 0);
                    if (!ok0) p0[r] = -INFINITY; if (!ok1) p1[r] = -INFINITY; }
            }
        }
        float r0 = p0[0], r1 = p1[0];
#pragma unroll
        for (int r = 1; r < 16; ++r) { r0 = fmaxf(r0, p0[r]); r1 = fmaxf(r1, p1[r]); }
        const float rm = swap_max(fmaxf(r0, r1));
        const bool valid = rm > -1e37f;
        float dl = 0.f;
        if (__any(valid && (!mset || rm > THR))) {
            dl = valid ? (mset ? fmaxf(rm, 0.f) : rm) : 0.f;
            const float alpha = mset ? ex2(-dl) : 1.f;
            m += dl; l *= alpha; mset = mset || valid;
#pragma unroll
            for (int r = 0; r < 16; ++r) { p0[r] -= dl; p1[r] -= dl; }
            asm volatile("" ::: "memory");
            if (hi == 0) wsf[r32] = alpha;
            asm volatile("s_waitcnt lgkmcnt(0)" ::: "memory");
#pragma unroll
            for (int r = 0; r < 16; ++r) { const float al = wsf[crow(r, hi)];
#pragma unroll
                for (int d = 0; d < NDB; ++d) o[d][r] *= al; }
            asm volatile("" ::: "memory");
        }
        const float rmn = valid ? rm - dl : -INFINITY;
        const bool skip = (MODE == 0) && __all(rmn < -SKIPT && (mset || !valid));
        if (!skip) {
        float sacc = 0.f;
#pragma unroll
        for (int r = 0; r < 16; ++r) { p0[r] = ex2(p0[r]); p1[r] = ex2(p1[r]); sacc += p0[r] + p1[r]; }
        l += sacc;
        u32x4 pw[4];
        pw[0] = (u32x4){cvtpk(p0[0], p0[1]), cvtpk(p0[2], p0[3]), cvtpk(p0[4], p0[5]), cvtpk(p0[6], p0[7])};
        pw[1] = (u32x4){cvtpk(p0[8], p0[9]), cvtpk(p0[10], p0[11]), cvtpk(p0[12], p0[13]), cvtpk(p0[14], p0[15])};
        pw[2] = (u32x4){cvtpk(p1[0], p1[1]), cvtpk(p1[2], p1[3]), cvtpk(p1[4], p1[5]), cvtpk(p1[6], p1[7])};
        pw[3] = (u32x4){cvtpk(p1[8], p1[9]), cvtpk(p1[10], p1[11]), cvtpk(p1[12], p1[13]), cvtpk(p1[14], p1[15])};
        const LAS char* vp = (const LAS char*)(lds + vb + vad);
        { constexpr int NF = NDB * 4;
          s16x4 flo[3], fhi[3];
#define FA_VRD(i_, slot_) do { flo[slot_] = vtr(vp + ((i_) >> 2) * 4096 + ((i_) & 3) * 1024); fhi[slot_] = vtr(vp + ((i_) >> 2) * 4096 + ((i_) & 3) * 1024 + 512); } while (0)
          FA_VRD(0, 0); FA_VRD(1, 1);
#pragma unroll
          for (int i = 0; i < NF; ++i) {
            if (i + 2 < NF) FA_VRD(i + 2 < NF ? i + 2 : 0, (i + 2) % 3);
            __builtin_amdgcn_sched_barrier(0);
            const s16x4 lo = flo[i % 3], hh = fhi[i % 3];
            const bf16x8 vf = (bf16x8){lo[0], lo[1], lo[2], lo[3], hh[0], hh[1], hh[2], hh[3]};
            o[i >> 2] = __builtin_amdgcn_mfma_f32_32x32x16_bf16(__builtin_bit_cast(bf16x8, pw[i & 3]), vf, o[i >> 2], 0, 0, 0);
            __builtin_amdgcn_sched_barrier(0);
          }
#undef FA_VRD
        }
        }
        }
        }
        if (MODE == 0) {
            const bool done = __all(mset && (qn + slope2 * (float)(64 * tn + 63 - qpos) - m < -SKIPT));
            if (lane == 0) xfl[(ib & 1) * 8 + wid] = done ? 1u : 0u;
        }
        asm volatile("s_waitcnt vmcnt(0)" ::: "memory");
        __syncthreads();
        cur ^= 1;
        if (MODE == 0) {
            const LAS unsigned* f = xfl + (ib & 1) * 8;
            const unsigned all = (f[0] & f[1]) & (f[2] & f[3]) & (f[4] & f[5]) & (f[6] & f[7]);
            if (__builtin_amdgcn_readfirstlane(all)) break;
        }
    }
#undef FA_DMA
    l = swap_add(l);
    const float inv = 1.f / l;
    asm volatile("" ::: "memory");
    if (hi == 0) wsf[r32] = inv;
    asm volatile("s_waitcnt lgkmcnt(0)" ::: "memory");
#pragma unroll
    for (int r = 0; r < 16; ++r) { const float a = wsf[crow(r, hi)];
#pragma unroll
        for (int d = 0; d < NDB; ++d) o[d][r] *= a; }
    asm volatile("" ::: "memory");
}

template <int NDB>
__device__ __forceinline__ void store_o(bf16_t* Ow, int opitch, const f32x16 (&o)[NDB], int r32, int hi, int dry) {
    if (dry) return;
#pragma unroll
    for (int r = 0; r < 16; ++r) { bf16_t* p = Ow + (size_t)crow(r, hi) * opitch + r32;
#pragma unroll
        for (int d = 0; d < NDB; ++d) p[d * 32] = (bf16_t)(cvtpk(o[d][r], 0.f) & 0xffffu); }
}
}


#define XB_TMO      128
#define XB_XCNT(j)  (256  + 64 * (j))
#define XB_XSUB(j)  (1280 + 64 * (j))
#define XB_XGEN(j)  (2304 + 64 * (j))
#define XB_TOP      3328
#define XB_TOPGEN   3392
#define XCD_BAR_WORDS 3456
#define XB_SPIN_CAP (1u << 18)
__device__ __forceinline__ unsigned xb_ld(unsigned* p)              { return __hip_atomic_load(p, __ATOMIC_RELAXED, __HIP_MEMORY_SCOPE_AGENT); }
__device__ __forceinline__ unsigned xb_add(unsigned* p, unsigned v) { return __hip_atomic_fetch_add(p, v, __ATOMIC_RELAXED, __HIP_MEMORY_SCOPE_AGENT); }
__device__ __forceinline__ unsigned xb_xcc_id() { return (unsigned)__builtin_amdgcn_s_getreg((3 << 11) | 20) & 0xFu; }
#define XB_SPIN(cond, bar) do { unsigned _sp = 0; while (cond) { __builtin_amdgcn_s_sleep(1); \
    if ((++_sp & 255u) == 0u) { if (xb_ld(&(bar)[XB_TMO])) break; if (_sp > XB_SPIN_CAP) { atomicAdd(&(bar)[XB_TMO], 1u); break; } } } } while (0)
struct XcdBarrier { unsigned* bar; unsigned x; volatile LAS unsigned* st; };
__device__ __forceinline__ XcdBarrier xcd_barrier_post(unsigned* bar, volatile LAS unsigned* st) {
    XcdBarrier b; b.bar = bar; b.x = xb_xcc_id(); b.st = st;
    if (threadIdx.x == 0) (void)xb_add(&bar[XB_XCNT(b.x)], 1u);
    return b;
}
__device__ __forceinline__ void xcd_barrier_complete(unsigned* bar, unsigned x, unsigned& nloc, unsigned& nx) {
    const unsigned G = gridDim.x * gridDim.y * gridDim.z;
    unsigned sum, cnt, mine, sp = 0u;
    for (;;) {
        sum = 0u; cnt = 0u; mine = 0u;
#pragma unroll
        for (unsigned j = 0; j < 16; ++j) { const unsigned c = xb_ld(&bar[XB_XCNT(j)]); sum += c; cnt += (c > 0u) ? 1u : 0u; mine = (j == x) ? c : mine; }
        if (sum == G) break;
        __builtin_amdgcn_s_sleep(1);
        if ((++sp & 255u) == 0u) { if (xb_ld(&bar[XB_TMO])) break; if (sp > XB_SPIN_CAP) { atomicAdd(&bar[XB_TMO], 1u); break; } }
    }
    nloc = mine > 0u ? mine : 1u; nx = cnt > 0u ? cnt : 1u;
}
__device__ __forceinline__ void xcd_barrier(const XcdBarrier& b) {
    asm volatile("s_waitcnt vmcnt(0)" ::: "memory");
    __syncthreads();
    if (threadIdx.x == 0) {
        unsigned* bar = b.bar;
        __builtin_amdgcn_s_waitcnt(0);
        unsigned nloc = b.st[0], nx = b.st[1];
        if (nloc == 0u) { xcd_barrier_complete(bar, b.x, nloc, nx); b.st[0] = nloc; b.st[1] = nx; }
        const unsigned old = xb_add(&bar[XB_XSUB(b.x)], 1u);
        const unsigned gen = old / nloc;
        if (old + 1u == (gen + 1u) * nloc) {
            __builtin_amdgcn_fence(__ATOMIC_RELEASE, "agent");
            asm volatile("s_waitcnt vmcnt(0)" ::: "memory");
            const unsigned og = xb_add(&bar[XB_TOP], 1u);
            const unsigned tg = og / nx;
            if (og + 1u == (tg + 1u) * nx) xb_add(&bar[XB_TOPGEN], 1u);
            else XB_SPIN(xb_ld(&bar[XB_TOPGEN]) == tg, bar);
            __builtin_amdgcn_fence(__ATOMIC_ACQUIRE, "agent");
            xb_add(&bar[XB_XGEN(b.x)], 1u);
            asm volatile("s_waitcnt vmcnt(0)" ::: "memory");
        } else {
            XB_SPIN(xb_ld(&bar[XB_XGEN(b.x)]) == gen, bar);
            __builtin_amdgcn_fence(__ATOMIC_ACQUIRE, "agent");
            asm volatile("s_waitcnt vmcnt(0)" ::: "memory");
        }
    }
    __syncthreads();
}

struct Args { const float* in[20]; float* out; unsigned char* ws; int ph_lo, ph_hi; };
static_assert(sizeof(Args) == 22 * 8 + 8, "Args has no padding");

template <bool SWIGLU>
__device__ __forceinline__ void conv_item(const float* W, int Nsrc, int src_base, bf16_t* WT, int Kpitch, int nb, int kb, const float* gain, int lane) {
    const int nd = nb * 256 + 4 * lane;
    int sc;
    if (SWIGLU) { const int cc = 4 * lane; sc = (cc < 128) ? (nb * 128 + cc) : (FF + nb * 128 + cc - 128); } else sc = src_base + nd;
    const float* src = W + (size_t)(kb * 64) * Nsrc + sc;
    bf16_t* dst = WT + (size_t)nd * Kpitch + kb * 64;
#pragma unroll 4
    for (int c = 0; c < 8; ++c) {
        f32x4 v[8];
#pragma unroll
        for (int j = 0; j < 8; ++j) v[j] = *(const f32x4*)(src + (size_t)(c * 8 + j) * Nsrc);
        if (gain) {
#pragma unroll
            for (int j = 0; j < 8; ++j) v[j] = v[j] * gain[kb * 64 + c * 8 + j];
        }
#pragma unroll
        for (int i = 0; i < 4; ++i) { u32x4 o; o.x = cvtpk(v[0][i], v[1][i]); o.y = cvtpk(v[2][i], v[3][i]); o.z = cvtpk(v[4][i], v[5][i]); o.w = cvtpk(v[6][i], v[7][i]);
            *(u32x4*)(dst + (size_t)i * Kpitch + c * 8) = o; }
    }
}

__device__ __forceinline__ void convert_weights(const Args& a, unsigned char* ws, int l, LAS unsigned char* lds, int gw, int NGW, int wave, int lane) {
    const float* ffn1_wi = a.in[3] + (size_t)l * DM * 2 * FF; const float* ffn1_wo = a.in[4] + (size_t)l * FF * DM; const float* w_in = a.in[6] + (size_t)l * DM * INW;
    const float* w_mkv = a.in[11] + (size_t)l * DM * DM; const float* w_bd = a.in[12] + (size_t)l * DM * DM; const float* w_bs = a.in[13] + (size_t)l * 512 * DM;
    const float* w_bm = a.in[14] + (size_t)l * 512 * DM; const float* w_out = a.in[15] + (size_t)l * DM * DM; const float* ffn2_wi = a.in[17] + (size_t)l * DM * 2 * FF; const float* ffn2_wo = a.in[18] + (size_t)l * FF * DM;
    const float* g_ffn1 = a.in[2] + l * DM; const float* g_mix = a.in[5] + l * DM; const float* g_mem = a.in[10] + l * DM; const float* g_ffn2 = a.in[16] + l * DM;
    constexpr int I_WI = 22 * 16, I_WO = 4 * 44, I_IN = 17 * 16, I_G = 12 * 16, I_SQ = 4 * 16, I_BS = 4 * 8;
    constexpr int NITEMS = 2 * I_WI + 2 * I_WO + I_IN + I_G + 3 * I_SQ + 2 * I_BS;
    for (int it = gw; it < NITEMS; it += NGW) {
        int r = it;
        if (r < 2 * I_WI) { const bool second = r >= I_WI; if (second) r -= I_WI; const int kb = r / 22, nb = r % 22;
            conv_item<true>(second ? ffn2_wi : ffn1_wi, 2 * FF, 0, (bf16_t*)(ws + (second ? W_FFN2I : W_FFN1I)), DM, nb, kb, second ? g_ffn2 : g_ffn1, lane); continue; }
        r -= 2 * I_WI;
        if (r < 2 * I_WO) { const bool second = r >= I_WO; if (second) r -= I_WO; const int kb = r / 4, nb = r % 4;
            conv_item<false>(second ? ffn2_wo : ffn1_wo, DM, 0, (bf16_t*)(ws + (second ? W_FFN2O : W_FFN1O)), FF, nb, kb, nullptr, lane); continue; }
        r -= 2 * I_WO;
        if (r < I_IN) { const int kb = r / 17, nb = r % 17; conv_item<false>(w_in, INW, 0, (bf16_t*)(ws + W_IN), DM, nb, kb, g_mix, lane); continue; }
        r -= I_IN;
        if (r < I_G) { const int kb = r / 12, nb = r % 12; conv_item<false>(w_in, INW, PW, (bf16_t*)(ws + W_G), DM, nb, kb, g_mix, lane); continue; }
        r -= I_G;
        if (r < 3 * I_SQ) { const int which = r / I_SQ; r -= which * I_SQ; const int kb = r / 4, nb = r % 4;
            const float* src = which == 0 ? w_mkv : which == 1 ? w_bd : w_out; const size_t dst = which == 0 ? W_MKV : which == 1 ? W_BRD : W_OUT;
            conv_item<false>(src, DM, 0, (bf16_t*)(ws + dst), DM, nb, kb, which == 0 ? g_mem : nullptr, lane); continue; }
        r -= 3 * I_SQ;
        { const bool second = r >= I_BS; if (second) r -= I_BS; const int kb = r / 4, nb = r % 4;
            conv_item<false>(second ? w_bm : w_bs, DM, 0, (bf16_t*)(ws + (second ? W_BRM : W_BRS)), 1024, nb, kb, nullptr, lane); }
    }
}

__device__ __forceinline__ void rms_row_bf16(const float* xrow, bf16_t* orow, int lane) {
    const f32x4* xr = (const f32x4*)xrow + lane;
    f32x4 v[4]; float s = 0.f;
#pragma unroll
    for (int j = 0; j < 4; ++j) { v[j] = xr[64 * j]; s += (v[j].x * v[j].x + v[j].y * v[j].y) + (v[j].z * v[j].z + v[j].w * v[j].w); }
    const float rstd = 1.0f / sqrtf(wave_sum(s) * (1.f / DM) + EPS);
    u32x2* o8 = (u32x2*)orow + lane;
#pragma unroll
    for (int j = 0; j < 4; ++j) { u32x2 w; w.x = cvtpk(v[j].x * rstd, v[j].y * rstd); w.y = cvtpk(v[j].z * rstd, v[j].w * rstd); o8[64 * j] = w; }
}
__device__ __forceinline__ void rms_row2_bf16(const float* xrow, bf16_t* orow, size_t stride, int lane) {
    const f32x4* xa = (const f32x4*)xrow + lane; const f32x4* xb = (const f32x4*)(xrow + stride) + lane;
    f32x4 va[4], vb[4]; float sa = 0.f, sb = 0.f;
#pragma unroll
    for (int j = 0; j < 4; ++j) { va[j] = xa[64 * j]; vb[j] = xb[64 * j]; }
#pragma unroll
    for (int j = 0; j < 4; ++j) { sa += (va[j].x * va[j].x + va[j].y * va[j].y) + (va[j].z * va[j].z + va[j].w * va[j].w); sb += (vb[j].x * vb[j].x + vb[j].y * vb[j].y) + (vb[j].z * vb[j].z + vb[j].w * vb[j].w); }
    const float ra = 1.0f / sqrtf(wave_sum(sa) * (1.f / DM) + EPS), rb = 1.0f / sqrtf(wave_sum(sb) * (1.f / DM) + EPS);
    u32x2* oa = (u32x2*)orow + lane; u32x2* ob = (u32x2*)(orow + stride) + lane;
#pragma unroll
    for (int j = 0; j < 4; ++j) { u32x2 w; w.x = cvtpk(va[j].x * ra, va[j].y * ra); w.y = cvtpk(va[j].z * ra, va[j].w * ra); oa[64 * j] = w;
        u32x2 w2; w2.x = cvtpk(vb[j].x * rb, vb[j].y * rb); w2.y = cvtpk(vb[j].z * rb, vb[j].w * rb); ob[64 * j] = w2; }
}
__device__ __forceinline__ void rms_row2_b16(const bf16_t* srow, bf16_t* orow, size_t stride, int lane) {
    const u32x4* xa = (const u32x4*)srow + lane; const u32x4* xb = (const u32x4*)(srow + stride) + lane;
    u32x4 va[2], vb[2]; float sa = 0.f, sb = 0.f;
#pragma unroll
    for (int j = 0; j < 2; ++j) { va[j] = xa[64 * j]; vb[j] = xb[64 * j]; }
    float fa[16], fb[16];
#pragma unroll
    for (int j = 0; j < 2; ++j) { fa[8*j] = bf_lo(va[j].x); fa[8*j+1] = bf_hi(va[j].x); fa[8*j+2] = bf_lo(va[j].y); fa[8*j+3] = bf_hi(va[j].y); fa[8*j+4] = bf_lo(va[j].z); fa[8*j+5] = bf_hi(va[j].z); fa[8*j+6] = bf_lo(va[j].w); fa[8*j+7] = bf_hi(va[j].w);
        fb[8*j] = bf_lo(vb[j].x); fb[8*j+1] = bf_hi(vb[j].x); fb[8*j+2] = bf_lo(vb[j].y); fb[8*j+3] = bf_hi(vb[j].y); fb[8*j+4] = bf_lo(vb[j].z); fb[8*j+5] = bf_hi(vb[j].z); fb[8*j+6] = bf_lo(vb[j].w); fb[8*j+7] = bf_hi(vb[j].w); }
#pragma unroll
    for (int i = 0; i < 16; ++i) { sa += fa[i] * fa[i]; sb += fb[i] * fb[i]; }
    const float ra = 1.0f / sqrtf(wave_sum(sa) * (1.f / DM) + EPS), rb = 1.0f / sqrtf(wave_sum(sb) * (1.f / DM) + EPS);
    u32x4* oa = (u32x4*)orow + lane; u32x4* ob = (u32x4*)(orow + stride) + lane;
#pragma unroll
    for (int j = 0; j < 2; ++j) { u32x4 w; w.x = cvtpk(fa[8*j] * ra, fa[8*j+1] * ra); w.y = cvtpk(fa[8*j+2] * ra, fa[8*j+3] * ra); w.z = cvtpk(fa[8*j+4] * ra, fa[8*j+5] * ra); w.w = cvtpk(fa[8*j+6] * ra, fa[8*j+7] * ra); oa[64 * j] = w;
        u32x4 w2; w2.x = cvtpk(fb[8*j] * rb, fb[8*j+1] * rb); w2.y = cvtpk(fb[8*j+2] * rb, fb[8*j+3] * rb); w2.z = cvtpk(fb[8*j+4] * rb, fb[8*j+5] * rb); w2.w = cvtpk(fb[8*j+6] * rb, fb[8*j+7] * rb); ob[64 * j] = w2; }
}
__device__ __forceinline__ void rms_row_b16_f32(const bf16_t* srow, float* orow, const float* g, int lane) {
    const u32x4* xa = (const u32x4*)srow + lane; u32x4 va[2]; float s = 0.f; float f[16];
#pragma unroll
    for (int j = 0; j < 2; ++j) va[j] = xa[64 * j];
#pragma unroll
    for (int j = 0; j < 2; ++j) { f[8*j] = bf_lo(va[j].x); f[8*j+1] = bf_hi(va[j].x); f[8*j+2] = bf_lo(va[j].y); f[8*j+3] = bf_hi(va[j].y); f[8*j+4] = bf_lo(va[j].z); f[8*j+5] = bf_hi(va[j].z); f[8*j+6] = bf_lo(va[j].w); f[8*j+7] = bf_hi(va[j].w); }
#pragma unroll
    for (int i = 0; i < 16; ++i) s += f[i] * f[i];
    const float rstd = 1.0f / sqrtf(wave_sum(s) * (1.f / DM) + EPS);
#pragma unroll
    for (int j = 0; j < 2; ++j) { const f32x4* gp = (const f32x4*)(g + 512 * j + 8 * lane); f32x4* op = (f32x4*)(orow + 512 * j + 8 * lane);
        const f32x4 g0 = gp[0], g1 = gp[1];
        op[0] = (f32x4){f[8*j] * rstd * g0[0], f[8*j+1] * rstd * g0[1], f[8*j+2] * rstd * g0[2], f[8*j+3] * rstd * g0[3]};
        op[1] = (f32x4){f[8*j+4] * rstd * g1[0], f[8*j+5] * rstd * g1[1], f[8*j+6] * rstd * g1[2], f[8*j+7] * rstd * g1[3]}; }
}
__device__ __forceinline__ void raw_row2_bf16(const float* xrow, bf16_t* orow, float* ssq4, size_t stride, size_t sstride, int lane) {
    const f32x4* xa = (const f32x4*)xrow + lane; const f32x4* xb = (const f32x4*)(xrow + stride) + lane;
    f32x4 va[4], vb[4]; float sa = 0.f, sb = 0.f;
#pragma unroll
    for (int j = 0; j < 4; ++j) { va[j] = xa[64 * j]; vb[j] = xb[64 * j]; }
#pragma unroll
    for (int j = 0; j < 4; ++j) { sa += (va[j].x * va[j].x + va[j].y * va[j].y) + (va[j].z * va[j].z + va[j].w * va[j].w); sb += (vb[j].x * vb[j].x + vb[j].y * vb[j].y) + (vb[j].z * vb[j].z + vb[j].w * vb[j].w); }
    sa = wave_sum(sa); sb = wave_sum(sb);
    u32x2* oa = (u32x2*)orow + lane; u32x2* ob = (u32x2*)(orow + stride) + lane;
#pragma unroll
    for (int j = 0; j < 4; ++j) { u32x2 w; w.x = cvtpk(va[j].x, va[j].y); w.y = cvtpk(va[j].z, va[j].w); oa[64 * j] = w;
        u32x2 w2; w2.x = cvtpk(vb[j].x, vb[j].y); w2.y = cvtpk(vb[j].z, vb[j].w); ob[64 * j] = w2; }
    if (lane == 0) { *(f32x4*)ssq4 = (f32x4){sa, 0.f, 0.f, 0.f}; *(f32x4*)(ssq4 + sstride) = (f32x4){sb, 0.f, 0.f, 0.f}; }
}
__device__ __forceinline__ void rms_row_f32(const float* xrow, float* orow, const float* g, int lane) {
    const f32x4* xr = (const f32x4*)xrow + lane; const f32x4* gr = (const f32x4*)g + lane;
    f32x4 v[4]; float s = 0.f;
#pragma unroll
    for (int j = 0; j < 4; ++j) { v[j] = xr[64 * j]; s += (v[j].x * v[j].x + v[j].y * v[j].y) + (v[j].z * v[j].z + v[j].w * v[j].w); }
    const float rstd = 1.0f / sqrtf(wave_sum(s) * (1.f / DM) + EPS);
    f32x4* o = (f32x4*)orow + lane;
#pragma unroll
    for (int j = 0; j < 4; ++j) o[64 * j] = v[j] * rstd * gr[64 * j];
}

constexpr int FA_NMAX = 8;
__device__ const unsigned char fa_cnt[32] = {8, 8, 8, 8, 8, 8, 8, 8, 8, 8, 8, 8, 8, 8, 8, 8, 8, 8, 8, 8, 8, 8, 8, 8, 8, 8, 8, 8, 8, 8, 8, 8};
__device__ const unsigned char fa_tab[32][FA_NMAX] = {
    {255, 171, 161, 136, 111, 89, 52, 16},
    {234, 223, 139, 129, 110, 88, 51, 15},
    {254, 235, 138, 109, 97, 87, 50, 14},
    {222, 203, 137, 108, 86, 65, 49, 13},
    {253, 232, 204, 162, 120, 82, 48, 12},
    {221, 200, 172, 130, 119, 81, 47, 11},
    {252, 173, 168, 118, 98, 80, 46, 10},
    {236, 220, 145, 117, 95, 79, 45, 9},
    {251, 237, 144, 116, 94, 78, 44, 8},
    {219, 205, 143, 115, 93, 77, 43, 7},
    {250, 206, 142, 114, 92, 76, 42, 6},
    {218, 174, 141, 113, 91, 75, 41, 5},
    {249, 175, 140, 112, 90, 74, 40, 4},
    {238, 217, 195, 151, 126, 73, 39, 3},
    {248, 239, 163, 150, 125, 72, 38, 2},
    {216, 207, 149, 131, 124, 71, 37, 1},
    {247, 224, 208, 148, 123, 99, 70, 36},
    {226, 215, 176, 147, 122, 85, 57, 24},
    {246, 194, 177, 146, 121, 84, 56, 23},
    {240, 229, 214, 192, 156, 106, 63, 35},
    {245, 241, 197, 160, 155, 105, 62, 34},
    {213, 209, 165, 154, 128, 104, 61, 33},
    {244, 179, 153, 133, 103, 60, 31, 22},
    {212, 178, 152, 127, 107, 96, 69, 28},
    {243, 230, 181, 158, 102, 59, 30, 21},
    {211, 198, 180, 157, 101, 58, 29, 20},
    {242, 228, 202, 187, 166, 68, 64, 27},
    {210, 196, 186, 170, 134, 67, 32, 26},
    {233, 231, 191, 185, 164, 66, 25, 0},
    {225, 201, 199, 190, 184, 132, 55, 19},
    {193, 189, 183, 169, 167, 100, 54, 18},
    {227, 188, 182, 159, 135, 83, 53, 17}
};
__device__ __forceinline__ void attention_phase(const Args& a, unsigned char* ws, int l, LAS unsigned char* ldsu, int vcu0, int G, const int tid, const int dry) {
    LAS char* lds = (LAS char*)ldsu;
    const int lane = tid & 63, r32 = lane & 31, hi = lane >> 5; const int wid = __builtin_amdgcn_readfirstlane(tid >> 6);
    bf16_t* P = (bf16_t*)(ws + WS_P); const bf16_t* MKV = (const bf16_t*)(ws + WS_MKV);
    const float linit = 0.8f - 0.6f * expf(-0.3f * (float)l);
    float lam;
    { const float* lp = a.in[7] + l * 256; const float s1 = wave_sum(lp[lane] * lp[64 + lane]), s2 = wave_sum(lp[128 + lane] * lp[192 + lane]); lam = expf(s1) - expf(s2) + linit; }
    const float* gsub = a.in[8] + l * 128; const float* sinks = a.in[9] + l * 8;
    for (int vcu = vcu0; vcu < 256; vcu += G) {
        if (!(dry && !(PROBE_SUB & 1))) {
            const int b = vcu >> 5, j = vcu & 31;
            const int map = wid >> 2, w = wid & 3;
            const int nun = fa_cnt[j];
            for (int ui = 0; ui < nun; ++ui) {
                const int code_ = fa_tab[j][ui]; const int h = code_ >> 5, qb = code_ & 31;
                const float slope2 = exp2f(-(float)(h + 1)) * LOG2E;
                float gs[4];
#pragma unroll
                for (int d = 0; d < 4; ++d) gs[d] = gsub[d * 32 + r32] * (1.f - linit);
                const int q0 = qb * 128; const size_t rowb = (size_t)b * SEQ;
                const bf16_t* Qw = P + (rowb + q0 + 32 * w) * PW + C_QD + h * 128 + map * 64;
                const bf16_t* Kg = P + rowb * PW + C_KD + h * 128; const bf16_t* Vg = P + rowb * PW + C_VD + h * 128;
                f32x16 o[4];
                const unsigned* knp = (const unsigned*)(ws + WS_KNP) + l * 256 + ((b * 8 + h) * 2 + map) * 2;
                const float kn = sqrtf((__uint_as_float(knp[0]) + __uint_as_float(knp[1])) * 1.03f);
                fa::flash_core<64, 128, 128, 0>(lds, Qw, PW, Kg, PW, Vg, PW, 0, 0, 2 * qb + 2, map * 64, q0 + 32 * w + r32, slope2, -1e30f, 0.f, o, tid, kn);
                LAS float* X = (LAS float*)(lds + fa::L_XCH);
                if (map == 1) {
#pragma unroll
                    for (int d = 0; d < 4; ++d)
#pragma unroll
                        for (int r = 0; r < 16; ++r) X[(w * 128 + d * 32 + r32) * 33 + fa::crow(r, hi)] = o[d][r];
                }
                __syncthreads();
                if (map == 0) {
                    float ss[16];
#pragma unroll
                    for (int r = 0; r < 16; ++r) { float q = 0.f;
#pragma unroll
                        for (int d = 0; d < 4; ++d) { const float v = o[d][r] - lam * X[(w * 128 + d * 32 + r32) * 33 + fa::crow(r, hi)]; o[d][r] = v; q += v * v; }
                        ss[r] = q; }
#pragma unroll
                    for (int r = 0; r < 16; ++r) { float q = ss[r]; q += __shfl_xor(q, 1); q += __shfl_xor(q, 2); q += __shfl_xor(q, 4); q += __shfl_xor(q, 8); q += __shfl_xor(q, 16);
                        const float rstd = 1.0f / sqrtf(q * (1.f / 128.f) + EPS);
#pragma unroll
                        for (int d = 0; d < 4; ++d) o[d][r] *= rstd * gs[d]; }
                    fa::store_o<4>(P + (rowb + q0 + 32 * w) * PW + C_QD + h * 128, PW, o, r32, hi, dry);
                }
                __syncthreads();
            }
        }
        if (!(dry && !(PROBE_SUB & 2))) for (int i = 0; i < 4; ++i) {
            const int id = vcu * 4 + i, qblk = id & 63, kvh = (id >> 6) & 1, b = id >> 7;
            const int g = wid >> 1, rg = wid & 1, head = kvh * 4 + g;
            const int q0 = qblk * 64; const size_t rowb = (size_t)b * SEQ;
            const int kstart = q0 - 128, t0 = kstart < 0 ? (-kstart) / 64 : 0;
            const float slope2 = exp2f(-(float)(head + 1)) * LOG2E;
            const bf16_t* Qw = P + (rowb + q0 + 32 * rg) * PW + C_QS + head * 64;
            const bf16_t* Kg = P + rowb * PW + C_KS + kvh * 64; const bf16_t* Vg = P + rowb * PW + C_VS + kvh * 64;
            f32x16 o[2];
            fa::flash_core<64, 64, 64, 1>(lds, Qw, PW, Kg, PW, Vg, PW, kstart, t0, 3, 0, q0 + 32 * rg + r32, slope2, sinks[head] * LOG2E, 1.f, o, tid);
            fa::store_o<2>(P + (rowb + q0 + 32 * rg) * PW + C_QS + head * 64, PW, o, r32, hi, dry);
        }
        if (!(dry && !(PROBE_SUB & 4))) for (int i = 0; i < 2; ++i) {
            const int id = vcu * 2 + i, qblk = id & 15, mh = (id >> 4) & 3, b = id >> 6;
            const size_t rowb = (size_t)b * SEQ + qblk * 256 + 32 * wid;
            const bf16_t* Qw = P + rowb * PW + C_QM + mh * 128;
            const bf16_t* Kg = MKV + (size_t)b * MEMLEN * DM + mh * 128; const bf16_t* Vg = Kg + 512;
            f32x16 o[4];
            fa::flash_core<128, 128, 128, 2>(lds, Qw, PW, Kg, DM, Vg, DM, 0, 0, 4, 0, 0, 0.f, -1e30f, 0.f, o, tid);
            fa::store_o<4>(P + rowb * PW + C_QM + mh * 128, PW, o, r32, hi, dry);
        }
    }
}

__global__ void __launch_bounds__(NWAVES * 64, 2) mega_fwd(Args args) {
    extern __shared__ __attribute__((aligned(16))) unsigned char lds_raw[];
    LAS unsigned char* lds = (LAS unsigned char*)lds_raw;
    const int G = gridDim.x, bx = blockIdx.x;
    const int vcu = (G % 8 == 0) ? (bx % 8) * (G / 8) + bx / 8 : bx;
    const int NGW = G * NWAVES;
    const int lo = args.ph_lo, hi = args.ph_hi;
    volatile LAS unsigned* bst = (volatile LAS unsigned*)(lds + LDS_BYTES - 64);
    if (threadIdx.x < 2) bst[threadIdx.x] = 0u;
    __syncthreads();
    XcdBarrier bar = xcd_barrier_post((unsigned*)args.ws, bst);
    int second = 0;
    for (int p = lo; p < hi;) {
        if (p > lo) { if (hi > 1000000) cg::this_grid().sync(); xcd_barrier(bar); }
        int tid = threadIdx.x; asm volatile("" : "+v"(tid));
        unsigned char* ws = args.ws; asm volatile("" : "+s"(ws));
        const int lane = tid & 63; const int wave = __builtin_amdgcn_readfirstlane(tid >> 6);
        const int gw = vcu * NWAVES + wave;
        bf16_t* XN = (bf16_t*)(ws + WS_XN); bf16_t* MN = (bf16_t*)(ws + WS_MN); bf16_t* MKV = (bf16_t*)(ws + WS_MKV); bf16_t* P = (bf16_t*)(ws + WS_P); bf16_t* ACT = P; bf16_t* MRG = (bf16_t*)(ws + WS_MRG);
        unsigned char* const wsw1 = ws + (WS_XN - WS_W);
        if (p == 0) {
            convert_weights(args, ws, 0, lds, gw, NGW, wave, lane);
            convert_weights(args, wsw1, 1, lds, gw, NGW, wave, lane);
            for (int m = gw; m < M; m += 2 * NGW) raw_row2_bf16(args.in[0] + (size_t)m * DM, (bf16_t*)args.out + (size_t)m * DM, (float*)(ws + WS_SSQ) + (size_t)m * 4, (size_t)NGW * DM, (size_t)NGW * 4, lane);
            for (int m = gw; m < MR; m += NGW) rms_row_bf16(args.in[1] + (size_t)m * DM, MN + (size_t)m * DM, lane);
            __syncthreads();
            ++p; second = 0; continue;
        }
        if (p == N_PHASES_K - 1) {
            for (int m = gw; m < M; m += NGW) rms_row_b16_f32(MRG + (size_t)m * DM, args.out + (size_t)m * DM, args.in[19], lane);
            ++p; continue;
        }
        const int l = (p - 1) / 8, k = (p - 1) % 8;
        const int dry = 0;
        unsigned char* const wsl = (l == 0) ? ws : wsw1;
        bf16_t* const XS = (bf16_t*)args.out;
        float* const SSQ = (float*)(ws + WS_SSQ);
        if ((AB_MASK & 1) && (k == 0 || k == 6)) {
            pg8::SchedSimple S; S.T.init(M / 256, 2 * FF / 256); S.G = G; S.c = bx; S.A = (const char*)XS; S.B = (const char*)(wsl + (k == 0 ? W_FFN1I : W_FFN2I)); S.lda = 2048; S.ldb = 2048; S.nt = 16;
            pg8::EpiSwiglu E{ACT, SSQ + (size_t)(k == 0 ? 3 * l : 3 * l + 2) * M * 4};
            pg8::gemm_phase(lds, S, E, tid);
        } else if ((AB_MASK & 2) && (k == 1 || k == 7 || k == 5)) {
            pg8::SchedSimple S; S.T.init(M / 256, DM / 256); S.G = G; S.c = bx;
            if (k == 5) { S.A = (const char*)MRG; S.B = (const char*)(wsl + W_OUT); S.lda = 2048; S.ldb = 2048; S.nt = 16; }
            else { S.A = (const char*)ACT; S.B = (const char*)(wsl + (k == 1 ? W_FFN1O : W_FFN2O)); S.lda = FF * 2; S.ldb = FF * 2; S.nt = FF / 64; }
            pg8::EpiResidual E{nullptr, XS, (l == DEPTH - 1 && k == 7) ? MRG : XS, SSQ + (size_t)(3 * l + (k == 1 ? 1 : k == 5 ? 2 : 3)) * M * 4, k == 5 ? 2 : 1};
            pg8::gemm_phase(lds, S, E, tid);
        } else if ((AB_MASK & 4) && k == 2) {
            pg8::SchedProj S; S.T.init(M / 256, PW / 256); S.G = G; S.c = bx; S.XN = (const char*)XS; S.WIN = (const char*)(wsl + W_IN); S.MN = (const char*)MN; S.WMKV = (const char*)(wsl + W_MKV);
            pg8::EpiProj E{P, MKV, (unsigned*)(ws + WS_KNP) + l * 256, SSQ + (size_t)(3 * l + 1) * M * 4};
            pg8::gemm_phase(lds, S, E, tid);
        } else if ((AB_MASK & 8) && k == 3) {
            attention_phase(args, ws, l, lds, vcu, G, tid, dry);
        } else if ((AB_MASK & 16) && k == 4) {
            pg8::SchedBranch S; S.T.init(M / 256, DM / 256); S.G = G; S.c = bx; S.XN = (const char*)XS; S.P = (const char*)P; S.WG = (const char*)(wsl + W_G);
            S.WBD = (const char*)(wsl + W_BRD); S.WBS = (const char*)(wsl + W_BRS); S.WBM = (const char*)(wsl + W_BRM);
            pg8::EpiBranch E{(u32x4*)(ws + WS_G + (size_t)bx * 131072), MRG, SSQ + (size_t)(3 * l + 1) * M * 4, (u32x4*)((unsigned char*)args.out + 64 * MiB + (size_t)bx * 131072)};
            pg8::gemm_phase(lds, S, E, tid);
        }
        if (dry) second = 1; else { second = 0; ++p; }
    }
}

constexpr int N_PHASES = 1 + DEPTH * 8 + 1;

extern "C" void kernel_launch(void* const* d_in, const int* in_sizes, int n_in, void* d_out, int out_size, void* d_ws, size_t ws_size, hipStream_t stream) {
    static int grid = 0;
    if (grid == 0) {
        if (n_in != 20 || out_size != M * DM || ws_size < WS_END) { fprintf(stderr, "kernel_launch: unexpected problem (n_in %d, out %d, ws %zu < %zu)\n", n_in, out_size, ws_size, (size_t)WS_END); grid = -1; return; }
        int dev = 0, cus = 0, per_cu = 0;
        hipGetDevice(&dev); hipDeviceGetAttribute(&cus, hipDeviceAttributeMultiprocessorCount, dev);
        if (hipFuncSetAttribute((const void*)mega_fwd, hipFuncAttributeMaxDynamicSharedMemorySize, LDS_BYTES) != hipSuccess) { fprintf(stderr, "kernel_launch: hipFuncSetAttribute failed\n"); grid = -1; return; }
        hipOccupancyMaxActiveBlocksPerMultiprocessor(&per_cu, (const void*)mega_fwd, NWAVES * 64, LDS_BYTES);
        (void)hipGetLastError();
        if (per_cu < 1) { fprintf(stderr, "kernel_launch: occupancy query says %d blocks per CU\n", per_cu); per_cu = 1; }
        grid = cus;
    }
    if (grid < 0) return;
    if (hipMemsetAsync(d_ws, 0, 65536, stream) != hipSuccess) { fprintf(stderr, "kernel_launch: hipMemsetAsync failed\n"); return; }
    Args a{};
    for (int i = 0; i < 20; ++i) a.in[i] = (const float*)d_in[i];
    a.out = (float*)d_out; a.ws = (unsigned char*)d_ws;
#if MK_N_LAUNCHES == 1
    a.ph_lo = 0; a.ph_hi = N_PHASES;
    void* kargs[] = {&a};
    hipError_t e = hipLaunchCooperativeKernel((const void*)mega_fwd, dim3(grid), dim3(NWAVES * 64), kargs, LDS_BYTES, stream);
    if (e != hipSuccess) fprintf(stderr, "cooperative launch failed: %s (grid %d)\n", hipGetErrorString(e), grid);
#else
    for (int p = 0; p < N_PHASES; ++p) { a.ph_lo = p; a.ph_hi = p + 1; hipLaunchKernelGGL(mega_fwd, dim3(grid), dim3(NWAVES * 64), LDS_BYTES, stream, a); }
#endif
}
```

```cpp
#include <hip/hip_runtime.h>
#include <hip/hip_cooperative_groups.h>
#include <cstdio>
#include <cstdint>
namespace cg = cooperative_groups;

#ifndef MK_N_LAUNCHES
#define MK_N_LAUNCHES 1
#endif

#ifndef AB_MASK
#define AB_MASK 255
#endif
#ifndef PROBE_SUB
#define PROBE_SUB 6
#endif
#ifndef PROBE_K
#define PROBE_K 0
#endif
#define LAS __attribute__((address_space(3)))
typedef unsigned short bf16_t;
typedef short bf16x8 __attribute__((ext_vector_type(8)));
typedef short s16x4 __attribute__((ext_vector_type(4)));
typedef float f32x4 __attribute__((ext_vector_type(4)));
typedef float f32x16 __attribute__((ext_vector_type(16)));
typedef unsigned u32x4 __attribute__((ext_vector_type(4)));
typedef unsigned u32x2 __attribute__((ext_vector_type(2)));
typedef float f32x2_t __attribute__((ext_vector_type(2)));
typedef __bf16 bf16x2_t __attribute__((ext_vector_type(2)));

constexpr int BATCH = 8, SEQ = 4096, DM = 1024, FF = 2816, DEPTH = 2, MEMLEN = 256;
constexpr int M = BATCH * SEQ;
constexpr int MR = BATCH * MEMLEN;
constexpr int PW = 4352;
constexpr int C_QD = 0, C_KD = 1024, C_VD = 2048, C_QS = 3072, C_KS = 3584, C_VS = 3712, C_QM = 3840;
constexpr int INW = 7424;
constexpr float EPS = 1e-6f;
constexpr float LOG2E = 1.4426950408889634f;
constexpr float SQ64 = 0.125f * LOG2E;
constexpr float SQ128 = 0.08838834764831845f * LOG2E;

constexpr size_t MiB = 1u << 20;
constexpr size_t WS_W = 1 * MiB;
constexpr size_t W_FFN1I = WS_W + 0 * MiB, W_FFN1O = WS_W + 11 * MiB, W_IN = WS_W + 17 * MiB, W_G = WS_W + 26 * MiB, W_MKV = WS_W + 32 * MiB,
                 W_BRD = WS_W + 34 * MiB, W_BRS = WS_W + 36 * MiB, W_BRM = WS_W + 38 * MiB, W_OUT = WS_W + 40 * MiB, W_FFN2I = WS_W + 42 * MiB, W_FFN2O = WS_W + 53 * MiB;
constexpr size_t WS_XN = 60 * MiB;
constexpr size_t WS_MN = 124 * MiB;
constexpr size_t WS_MKV = 128 * MiB;
constexpr size_t WS_P = 132 * MiB;
constexpr size_t WS_MRG = 404 * MiB;
constexpr size_t WS_G = 468 * MiB;
constexpr size_t WS_SSQ = 500 * MiB;
constexpr size_t WS_END = 504 * MiB;

constexpr size_t WS_KNP = 32768;
constexpr int N_PHASES_K = 1 + 2 * 8 + 1;
constexpr int NWAVES = 8;
constexpr int LDS_BYTES = 147456;

__device__ __forceinline__ unsigned cvtpk(float lo, float hi) { f32x2_t v = {lo, hi}; bf16x2_t b = __builtin_convertvector(v, bf16x2_t); return __builtin_bit_cast(unsigned, b); }
__device__ __forceinline__ float bf_lo(unsigned w) { return __uint_as_float(w << 16); }
__device__ __forceinline__ float bf_hi(unsigned w) { return __uint_as_float(w & 0xffff0000u); }
__device__ __forceinline__ float ex2(float x) { return __builtin_amdgcn_exp2f(x); }
__device__ __forceinline__ float sigm(float x) { return __builtin_amdgcn_rcpf(1.f + ex2(-LOG2E * x)); }
__device__ __forceinline__ float rstd_of(const float* ssq4, int row) { if (!ssq4) return 1.f; const f32x4 p = *(const f32x4*)(ssq4 + (size_t)row * 4); return __builtin_amdgcn_rsqf(((p.x + p.y) + (p.z + p.w)) * (1.f / 1024.f) + 1e-6f); }
__device__ __forceinline__ float wave_sum(float v) {
#pragma unroll
    for (int o = 1; o < 64; o <<= 1) v += __shfl_xor(v, o);
    return v;
}

namespace pg8 {
constexpr int BM = 256, BK = 64, HALF = 128, HTB = HALF * BK * 2, STAGE_BYTES = 8 * HTB, NXCD = 8, WGM = 4;
__device__ __forceinline__ int lds_byte(int r, int c) { const int st = (r >> 4) * 2 + (c >> 5), rr = r & 15, cc = c & 31, ob = rr * 64 + cc * 2; return st * 1024 + (ob ^ (((ob >> 9) & 1) << 5)); }
__device__ __forceinline__ void stage_rc(int b, int& R, int& C) { const int st = b / 1024, sb = b % 1024, swz = sb ^ (((sb >> 9) & 1) << 5); R = (st >> 1) * 16 + swz / 64; C = (st & 1) * 32 + (swz % 64) / 2; }
__device__ __forceinline__ int perm32(int rho) { const int n = rho >> 4, i = rho & 15; return 8 * (i >> 2) + 4 * n + (i & 3); }

struct GUnit { const char* A; const char* B; unsigned lda, ldb; int nt; int pm, pn, kind; };

struct TileOrder {
    int nM, nN, nwg;
    __device__ __forceinline__ void init(int nM_, int nN_) { nM = nM_; nN = nN_; nwg = nM * nN; }
    __device__ __forceinline__ void tile(int L, int& pm, int& pn) const {
        int wgid = L; { const int q = nwg / NXCD, r = nwg % NXCD, xcd = wgid % NXCD, off = wgid / NXCD; wgid = (xcd < r ? xcd * (q + 1) : r * (q + 1) + (xcd - r) * q) + off; }
        const int nig = WGM * nN, gid = wgid / nig, fm = gid * WGM, gsz = (nM - fm) < WGM ? (nM - fm) : WGM;
        pm = fm + ((wgid % nig) % gsz); pn = (wgid % nig) / gsz;
    }
};

template <class Epi, class Sched>
__device__ __forceinline__ void gemm_phase(LAS unsigned char* lds, const Sched& S, const Epi& E, const int tid) {
    const int wid = __builtin_amdgcn_readfirstlane(tid >> 6), lane = tid & 63, wr = wid >> 2, wc = wid & 3, fr = lane & 15, fq = lane >> 4;
    int R0, C0; stage_rc(tid * 16, R0, C0);
    const int Rb0 = Epi::PERM ? ((R0 & ~31) + perm32(R0 & 31)) : R0;
    const size_t kstep = (size_t)(BK * 2);
    const unsigned ldsw = (unsigned)wid * 1024u;
    const int aoff = lds_byte(wr * 64 + fr, fq * 8), boff = lds_byte(wc * 32 + fr, fq * 8);
#define PG8_SA(b, h) (((b) * 2 + (h)) * HTB)
#define PG8_SB(b, h) ((4 + (b) * 2 + (h)) * HTB)
#define PG8_STAGE(bufoff, gbase, v0, q64) do { \
        __builtin_amdgcn_global_load_lds((const unsigned*)((const char*)(gbase) + (v0)), (LAS unsigned*)(lds + (bufoff) + ldsw), 16, 0, 0); \
        __builtin_amdgcn_global_load_lds((const unsigned*)((const char*)(gbase) + (q64) + (v0)), (LAS unsigned*)(lds + (bufoff) + ldsw + 8192), 16, 0, 0); } while (0)
#define PG8_LDA(dst, b, h) do { _Pragma("unroll") for (int m = 0; m < 4; ++m) _Pragma("unroll") for (int k = 0; k < 2; ++k) dst[m][k] = *(const LAS bf16x8*)(lds + PG8_SA(b, h) + aoff + m * 2048 + k * 1024); } while (0)
#define PG8_LDB(dst, b, h) do { _Pragma("unroll") for (int n = 0; n < 2; ++n) _Pragma("unroll") for (int k = 0; k < 2; ++k) dst[n][k] = *(const LAS bf16x8*)(lds + PG8_SB(b, h) + boff + n * 2048 + k * 1024); } while (0)
#define PG8_MMA(ai, bj, At, Bt) do { __builtin_amdgcn_s_setprio(1); _Pragma("unroll") for (int m = 0; m < 4; ++m) _Pragma("unroll") for (int n = 0; n < 2; ++n) _Pragma("unroll") for (int k = 0; k < 2; ++k) \
        acc[ai][bj][m][n] = __builtin_amdgcn_mfma_f32_16x16x32_bf16(Bt[n][k], At[m][k], acc[ai][bj][m][n], 0, 0, 0); __builtin_amdgcn_s_setprio(0); } while (0)
#define PG8_WAIT_V(n) asm volatile("s_waitcnt vmcnt(" #n ")" ::: "memory")
#define PG8_WAIT_L(n) asm volatile("s_waitcnt lgkmcnt(" #n ")" ::: "memory")
#define PG8_BAR __builtin_amdgcn_s_barrier()
#define PG8_SCHED __builtin_amdgcn_sched_barrier(0)
    GUnit cur, nxt; int ui = 0;
    if (!S.next(0, cur)) return;
    f32x4 acc[2][2][4][2];
#pragma unroll
    for (int a = 0; a < 2; ++a)
#pragma unroll
        for (int b = 0; b < 2; ++b)
#pragma unroll
            for (int m = 0; m < 4; ++m)
#pragma unroll
                for (int n = 0; n < 2; ++n) acc[a][b][m][n] = (f32x4){0.f, 0.f, 0.f, 0.f};
    bf16x8 At[4][2], B0[2][2], B1[2][2];
    const char* cA = cur.A; const char* cB = cur.B;
    unsigned vAc = (unsigned)R0 * cur.lda + (unsigned)C0 * 2u, vBc = (unsigned)Rb0 * cur.ldb + (unsigned)C0 * 2u;
    size_t hAc = (size_t)HALF * cur.lda, hBc = (size_t)HALF * cur.ldb;
    PG8_STAGE(PG8_SB(0, 0), cB, vBc, hBc / 2); PG8_STAGE(PG8_SB(0, 1), cB + hBc, vBc, hBc / 2); PG8_STAGE(PG8_SA(0, 0), cA, vAc, hAc / 2); PG8_STAGE(PG8_SA(0, 1), cA + hAc, vAc, hAc / 2);
    if (wr == 1) PG8_BAR;
    PG8_WAIT_V(2); PG8_BAR;
    PG8_STAGE(PG8_SB(1, 0), cB + kstep, vBc, hBc / 2); PG8_STAGE(PG8_SA(1, 0), cA + kstep, vAc, hAc / 2); PG8_STAGE(PG8_SB(1, 1), cB + hBc + kstep, vBc, hBc / 2);
    PG8_WAIT_V(6); PG8_BAR;
    for (;;) {
        const bool has_next = S.next(ui + 1, nxt);
        if (!has_next) nxt = cur;
        const char* nA = nxt.A; const char* nB = nxt.B;
        unsigned vAn = vAc, vBn = vBc;
        if (Sched::VARLDA) vAn = (unsigned)R0 * nxt.lda + (unsigned)C0 * 2u;
        if (Sched::VARLDB) vBn = (unsigned)Rb0 * nxt.ldb + (unsigned)C0 * 2u;
        const size_t hAn = (size_t)HALF * nxt.lda, hBn = (size_t)HALF * nxt.ldb;
        const int nt = cur.nt;
        for (int t = 0; t < nt; t += 2) {
            const bool last = (t == nt - 2);
            const char* a1 = cA + (size_t)(t + 1) * kstep;
            const char* a2 = last ? nA : cA + (size_t)(t + 2) * kstep; const char* b2 = last ? nB : cB + (size_t)(t + 2) * kstep;
            const char* a3 = a2 + kstep; const char* b3 = b2 + kstep;
            const unsigned vA = (Sched::VARLDA && last) ? vAn : vAc, vB = (Sched::VARLDB && last) ? vBn : vBc;
            const size_t hA = last ? hAn : hAc, hB = last ? hBn : hBc;
            PG8_LDB(B0, 0, 0); PG8_LDB(B1, 0, 1); PG8_SCHED; PG8_LDA(At, 0, 0); PG8_STAGE(PG8_SA(1, 1), a1 + hAc, vAc, hAc / 2);
            PG8_WAIT_V(8); PG8_WAIT_L(0); PG8_BAR; PG8_MMA(0, 0, At, B0); PG8_MMA(0, 1, At, B1); PG8_BAR; PG8_SCHED;
            PG8_LDA(At, 0, 1); PG8_STAGE(PG8_SB(0, 0), b2, vB, hB / 2); PG8_STAGE(PG8_SB(0, 1), b2 + hB, vB, hB / 2); PG8_STAGE(PG8_SA(0, 0), a2, vA, hA / 2);
            PG8_WAIT_V(8); PG8_WAIT_L(0); PG8_BAR; PG8_MMA(1, 0, At, B0); PG8_MMA(1, 1, At, B1); PG8_BAR; PG8_SCHED;
            PG8_LDB(B0, 1, 0); PG8_LDB(B1, 1, 1); PG8_SCHED; PG8_LDA(At, 1, 0); PG8_STAGE(PG8_SA(0, 1), a2 + hA, vA, hA / 2);
            PG8_WAIT_V(8); PG8_WAIT_L(0); PG8_BAR; PG8_MMA(0, 0, At, B0); PG8_MMA(0, 1, At, B1); PG8_BAR; PG8_SCHED;
            PG8_LDA(At, 1, 1); PG8_STAGE(PG8_SB(1, 0), b3, vB, hB / 2); PG8_STAGE(PG8_SB(1, 1), b3 + hB, vB, hB / 2); PG8_STAGE(PG8_SA(1, 0), a3, vA, hA / 2);
            PG8_WAIT_V(8); PG8_WAIT_L(0); PG8_BAR; PG8_MMA(1, 0, At, B0); PG8_MMA(1, 1, At, B1); PG8_BAR; PG8_SCHED;
        }
        if (wr == 0) PG8_BAR;
        E(acc, cur, wr, wc, fr, fq, tid, lds);
        if (!has_next) break;
#pragma unroll
        for (int a = 0; a < 2; ++a)
#pragma unroll
            for (int b = 0; b < 2; ++b)
#pragma unroll
                for (int m = 0; m < 4; ++m)
#pragma unroll
                    for (int n = 0; n < 2; ++n) acc[a][b][m][n] = (f32x4){0.f, 0.f, 0.f, 0.f};
        cur = nxt; cA = nA; cB = nB; vAc = vAn; vBc = vBn; hAc = hAn; hBc = hBn; ++ui;
        if (wr == 1) PG8_BAR;
    }
    PG8_WAIT_V(0);
    PG8_BAR;
#undef PG8_SA
#undef PG8_SB
#undef PG8_STAGE
#undef PG8_LDA
#undef PG8_LDB
#undef PG8_MMA
#undef PG8_WAIT_V
#undef PG8_WAIT_L
#undef PG8_BAR
#undef PG8_SCHED
}

struct EpiSwiglu {
    static constexpr bool PERM = true;
    bf16_t* O; const float* ssq;
    __device__ __forceinline__ void operator()(const f32x4 (&acc)[2][2][4][2], const GUnit& u, int wr, int wc, int fr, int fq, int tid, LAS unsigned char* lds) const {
        const int row0 = u.pm * BM + wr * 64 + fr, col0 = u.pn * 128 + wc * 32 + 8 * fq;
#pragma unroll
        for (int ai = 0; ai < 2; ++ai)
#pragma unroll
            for (int m = 0; m < 4; ++m) {
                bf16_t* rowp = O + (size_t)(row0 + ai * HALF + m * 16) * FF + col0;
                const float rs = rstd_of(ssq, row0 + ai * HALF + m * 16);
                float v[8];
#pragma unroll
                for (int n = 0; n < 2; ++n)
#pragma unroll
                    for (int j = 0; j < 4; ++j) { const float a = acc[ai][0][m][n][j] * rs, b = acc[ai][1][m][n][j] * rs; v[n * 4 + j] = a * sigm(a) * b; }
                u32x4 w; w.x = cvtpk(v[0], v[1]); w.y = cvtpk(v[2], v[3]); w.z = cvtpk(v[4], v[5]); w.w = cvtpk(v[6], v[7]);
                *(u32x4*)rowp = w;
            }
    }
};
struct EpiResidual {
    static constexpr bool PERM = true;
    const float* base32; const bf16_t* base16; bf16_t* out16; float* ssq; int mode;
    __device__ __forceinline__ void operator()(const f32x4 (&acc)[2][2][4][2], const GUnit& u, int wr, int wc, int fr, int fq, int tid, LAS unsigned char* lds) const {
        const float s = (mode == 0) ? 0.f : (mode == 1) ? 0.5f : 1.f;
        const int col0 = u.pn * BM + wc * 32 + 8 * fq;
        LAS float* Pl = (LAS float*)(lds + STAGE_BYTES);
        float qs[2][4];
#pragma unroll
        for (int ai = 0; ai < 2; ++ai) {
#pragma unroll
            for (int m = 0; m < 4; ++m) qs[ai][m] = 0.f;
            if (base32) {
                f32x4 bs[4][2][2];
#pragma unroll
                for (int m = 0; m < 4; ++m) { const size_t off = (size_t)(u.pm * BM + ai * HALF + wr * 64 + m * 16 + fr) * DM + col0;
#pragma unroll
                    for (int bj = 0; bj < 2; ++bj)
#pragma unroll
                        for (int n = 0; n < 2; ++n) bs[m][bj][n] = *(const f32x4*)(base32 + off + bj * HALF + n * 4); }
                asm volatile("" ::: "memory");
#pragma unroll
                for (int m = 0; m < 4; ++m) { const size_t off = (size_t)(u.pm * BM + ai * HALF + wr * 64 + m * 16 + fr) * DM + col0;
#pragma unroll
                    for (int bj = 0; bj < 2; ++bj) { const f32x4 v0 = bs[m][bj][0] + acc[ai][bj][m][0] * s, v1 = bs[m][bj][1] + acc[ai][bj][m][1] * s;
                        u32x4 w; w.x = cvtpk(v0[0], v0[1]); w.y = cvtpk(v0[2], v0[3]); w.z = cvtpk(v1[0], v1[1]); w.w = cvtpk(v1[2], v1[3]);
                        qs[ai][m] += ((v0[0] * v0[0] + v0[1] * v0[1]) + (v0[2] * v0[2] + v0[3] * v0[3])) + ((v1[0] * v1[0] + v1[1] * v1[1]) + (v1[2] * v1[2] + v1[3] * v1[3]));
                        *(u32x4*)(out16 + off + bj * HALF) = w; } }
            } else {
                u32x4 bs[4][2];
#pragma unroll
                for (int m = 0; m < 4; ++m) { const size_t off = (size_t)(u.pm * BM + ai * HALF + wr * 64 + m * 16 + fr) * DM + col0;
#pragma unroll
                    for (int bj = 0; bj < 2; ++bj) bs[m][bj] = *(const u32x4*)(base16 + off + bj * HALF); }
                asm volatile("" ::: "memory");
#pragma unroll
                for (int m = 0; m < 4; ++m) { const size_t off = (size_t)(u.pm * BM + ai * HALF + wr * 64 + m * 16 + fr) * DM + col0;
#pragma unroll
                    for (int bj = 0; bj < 2; ++bj) { const u32x4 b = bs[m][bj]; const f32x4 a0 = acc[ai][bj][m][0] * s, a1 = acc[ai][bj][m][1] * s;
                        const f32x4 v0 = (f32x4){bf_lo(b.x) + a0[0], bf_hi(b.x) + a0[1], bf_lo(b.y) + a0[2], bf_hi(b.y) + a0[3]}, v1 = (f32x4){bf_lo(b.z) + a1[0], bf_hi(b.z) + a1[1], bf_lo(b.w) + a1[2], bf_hi(b.w) + a1[3]};
                        u32x4 w; w.x = cvtpk(v0[0], v0[1]); w.y = cvtpk(v0[2], v0[3]); w.z = cvtpk(v1[0], v1[1]); w.w = cvtpk(v1[2], v1[3]);
                        qs[ai][m] += ((v0[0] * v0[0] + v0[1] * v0[1]) + (v0[2] * v0[2] + v0[3] * v0[3])) + ((v1[0] * v1[0] + v1[1] * v1[1]) + (v1[2] * v1[2] + v1[3] * v1[3]));
                        *(u32x4*)(out16 + off + bj * HALF) = w; } }
            }
            asm volatile("" ::: "memory");
        }
#pragma unroll
        for (int ai = 0; ai < 2; ++ai)
#pragma unroll
            for (int m = 0; m < 4; ++m) { float q = qs[ai][m]; q += __shfl_xor(q, 16); q += __shfl_xor(q, 32);
                if (fq == 0) Pl[(ai * HALF + wr * 64 + m * 16 + fr) * 4 + wc] = q; }
        asm volatile("s_waitcnt lgkmcnt(0)" ::: "memory"); __builtin_amdgcn_s_barrier(); asm volatile("" ::: "memory");
        if (tid < 256) { const f32x4 p = *(const LAS f32x4*)(Pl + tid * 4); ssq[(size_t)(u.pm * BM + tid) * 4 + u.pn] = (p.x + p.y) + (p.z + p.w); }
        asm volatile("s_waitcnt lgkmcnt(0)" ::: "memory"); __builtin_amdgcn_s_barrier(); asm volatile("" ::: "memory");
    }
};
struct EpiProj {
    static constexpr bool PERM = true;
    bf16_t* P; bf16_t* MKV; unsigned* KNP; const float* ssq;
    __device__ __forceinline__ void operator()(const f32x4 (&acc)[2][2][4][2], const GUnit& u, int wr, int wc, int fr, int fq, int tid, LAS unsigned char* lds) const {
        float sc = 1.f; bf16_t* base; size_t ld;
        if (u.kind == 0) { base = P; ld = PW; const int pn = u.pn; if (pn < 4 || pn == 12 || pn == 13) sc = SQ64; else if (pn == 15 || pn == 16) sc = SQ128; }
        else { base = MKV; ld = DM; }
        const int row0 = u.pm * BM + wr * 64 + fr, col0 = u.pn * BM + wc * 32 + 8 * fq;
        const bool isk = (u.kind == 0 && u.pn >= 4 && u.pn < 8);
        float mx0 = 0.f, mx1 = 0.f;
#pragma unroll
        for (int ai = 0; ai < 2; ++ai)
#pragma unroll
            for (int m = 0; m < 4; ++m) {
                bf16_t* rowp = base + (size_t)(row0 + ai * HALF + m * 16) * ld + col0;
                const float scr = (u.kind == 0) ? sc * rstd_of(ssq, row0 + ai * HALF + m * 16) : sc;
#pragma unroll
                for (int bj = 0; bj < 2; ++bj) { const f32x4 v0 = acc[ai][bj][m][0] * scr, v1 = acc[ai][bj][m][1] * scr;
                    u32x4 w; w.x = cvtpk(v0[0], v0[1]); w.y = cvtpk(v0[2], v0[3]); w.z = cvtpk(v1[0], v1[1]); w.w = cvtpk(v1[2], v1[3]);
                    *(u32x4*)(rowp + bj * HALF) = w;
                    float q = ((v0[0] * v0[0] + v0[1] * v0[1]) + (v0[2] * v0[2] + v0[3] * v0[3])) + ((v1[0] * v1[0] + v1[1] * v1[1]) + (v1[2] * v1[2] + v1[3] * v1[3]));
                    if (isk) { q += __shfl_xor(q, 16); q += __shfl_xor(q, 32); if (bj == 0) mx0 = fmaxf(mx0, q); else mx1 = fmaxf(mx1, q); } }
            }
        if (u.kind == 0 && u.pn >= 4 && u.pn < 8) {
#pragma unroll
            for (int o = 1; o < 16; o <<= 1) { mx0 = fmaxf(mx0, __shfl_xor(mx0, o)); mx1 = fmaxf(mx1, __shfl_xor(mx1, o)); }
            if ((tid & 63) == 0) { const int b = u.pm >> 4, h0 = (u.pn - 4) * 2;
                __hip_atomic_fetch_max(KNP + ((b * 8 + h0) * 2 + (wc >> 1)) * 2 + (wc & 1), __float_as_uint(mx0), __ATOMIC_RELAXED, __HIP_MEMORY_SCOPE_AGENT);
                __hip_atomic_fetch_max(KNP + ((b * 8 + h0 + 1) * 2 + (wc >> 1)) * 2 + (wc & 1), __float_as_uint(mx1), __ATOMIC_RELAXED, __HIP_MEMORY_SCOPE_AGENT); }
        }
    }
};
struct EpiBranch {
    static constexpr bool PERM = true;
    u32x4* G;
    bf16_t* MRG;
    const float* ssq;
    u32x4* PS;
    __device__ __forceinline__ void operator()(const f32x4 (&acc)[2][2][4][2], const GUnit& u, int wr, int wc, int fr, int fq, int tid, LAS unsigned char* lds) const {
        const int row0 = u.pm * BM + wr * 64 + fr, col0 = u.pn * BM + wc * 32 + 8 * fq;
        const __amdgpu_buffer_rsrc_t grs = __builtin_amdgcn_make_buffer_rsrc((void*)G, (short)0, 131072, 0x00020000);
        const __amdgpu_buffer_rsrc_t prs = __builtin_amdgcn_make_buffer_rsrc((void*)PS, (short)0, 131072, 0x00020000);
        if ((u.kind & 1) == 0) {
#pragma unroll
            for (int ai = 0; ai < 2; ++ai)
#pragma unroll
                for (int bj = 0; bj < 2; ++bj)
#pragma unroll
                    for (int m = 0; m < 4; ++m) { const float rs = rstd_of(ssq, row0 + ai * HALF + m * 16); const f32x4 a = acc[ai][bj][m][0] * rs, b = acc[ai][bj][m][1] * rs;
                        u32x4 w; w.x = cvtpk(sigm(a[0]), sigm(a[1])); w.y = cvtpk(sigm(a[2]), sigm(a[3])); w.z = cvtpk(sigm(b[0]), sigm(b[1])); w.w = cvtpk(sigm(b[2]), sigm(b[3]));
                        __builtin_amdgcn_raw_buffer_store_b128(w, grs, tid * 16, ((ai * 2 + bj) * 4 + m) * 8192, 0); }
        } else {
            const bool addp = u.kind > 1;
#pragma unroll
            for (int ai = 0; ai < 2; ++ai) {
                u32x4 g[2][4], o[2][4];
#pragma unroll
                for (int bj = 0; bj < 2; ++bj)
#pragma unroll
                    for (int m = 0; m < 4; ++m) { g[bj][m] = __builtin_amdgcn_raw_buffer_load_b128(grs, tid * 16, ((ai * 2 + bj) * 4 + m) * 8192, 0);
                        o[bj][m] = addp ? __builtin_amdgcn_raw_buffer_load_b128(prs, tid * 16, ((ai * 2 + bj) * 4 + m) * 8192, 0) : (u32x4){0u, 0u, 0u, 0u}; }
                asm volatile("" ::: "memory");
#pragma unroll
                for (int bj = 0; bj < 2; ++bj)
#pragma unroll
                    for (int m = 0; m < 4; ++m) {
                        bf16_t* p = MRG + (size_t)(row0 + ai * HALF + m * 16) * DM + col0 + bj * HALF;
                        const f32x4 a = acc[ai][bj][m][0], b = acc[ai][bj][m][1]; const u32x4 gg = g[bj][m], oo = o[bj][m];
                        float v[8] = {a[0] * bf_lo(gg.x), a[1] * bf_hi(gg.x), a[2] * bf_lo(gg.y), a[3] * bf_hi(gg.y), b[0] * bf_lo(gg.z), b[1] * bf_hi(gg.z), b[2] * bf_lo(gg.w), b[3] * bf_hi(gg.w)};
                        v[0] += bf_lo(oo.x); v[1] += bf_hi(oo.x); v[2] += bf_lo(oo.y); v[3] += bf_hi(oo.y); v[4] += bf_lo(oo.z); v[5] += bf_hi(oo.z); v[6] += bf_lo(oo.w); v[7] += bf_hi(oo.w);
                        u32x4 w; w.x = cvtpk(v[0], v[1]); w.y = cvtpk(v[2], v[3]); w.z = cvtpk(v[4], v[5]); w.w = cvtpk(v[6], v[7]);
                        if (u.kind == 5) *(u32x4*)p = w; else __builtin_amdgcn_raw_buffer_store_b128(w, prs, tid * 16, ((ai * 2 + bj) * 4 + m) * 8192, 0);
                    }
                asm volatile("" ::: "memory");
            }
        }
    }
};

struct SchedSimple {
    static constexpr bool VARLDA = false, VARLDB = false;
    TileOrder T; int G, c; const char* A; const char* B; unsigned lda, ldb; int nt;
    __device__ __forceinline__ bool next(int i, GUnit& u) const {
        const int L = i * G + c; if (L >= T.nwg) return false;
        int pm, pn; T.tile(L, pm, pn);
        u.A = A + (size_t)pm * BM * lda; u.B = B + (size_t)pn * BM * ldb; u.lda = lda; u.ldb = ldb; u.nt = nt; u.pm = pm; u.pn = pn; u.kind = 0; return true;
    }
};
struct SchedProj {
    static constexpr bool VARLDA = false, VARLDB = false;
    TileOrder T; int G, c; const char* XN; const char* WIN; const char* MN; const char* WMKV;
    __device__ __forceinline__ bool next(int i, GUnit& u) const {
        const int L = i * G + c;
        if (L < T.nwg) { int pm, pn; T.tile(L, pm, pn); u.A = XN + (size_t)pm * BM * 2048; u.B = WIN + (size_t)pn * BM * 2048; u.pm = pm; u.pn = pn; u.kind = 0; }
        else { const int r = L - T.nwg; if (r >= 32) return false; const int pm = r >> 2, pn = r & 3; u.A = MN + (size_t)pm * BM * 2048; u.B = WMKV + (size_t)pn * BM * 2048; u.pm = pm; u.pn = pn; u.kind = 1; }
        u.lda = 2048; u.ldb = 2048; u.nt = 16; return true;
    }
};
struct SchedBranch {
    static constexpr bool VARLDA = true, VARLDB = false;
    TileOrder T; int G, c; const char* XN; const char* P; const char* WG; const char* WBD; const char* WBS; const char* WBM;
    __device__ __forceinline__ bool next(int i, GUnit& u) const {
        const int pair = i / 6, sub = i - pair * 6; const int L = pair * G + c; if (L >= T.nwg) return false;
        int pm, pn; T.tile(L, pm, pn); u.pm = pm; u.pn = pn; u.kind = sub;
        if ((sub & 1) == 0) { u.A = XN + (size_t)pm * BM * 2048; u.lda = 2048; u.B = WG + (size_t)((sub >> 1) * 1024 + pn * BM) * 2048; u.ldb = 2048; u.nt = 16; }
        else if (sub == 1) { u.A = P + (size_t)pm * BM * (PW * 2) + C_QD * 2; u.lda = PW * 2; u.B = WBD + (size_t)pn * BM * 2048; u.ldb = 2048; u.nt = 16; }
        else if (sub == 3) { u.A = P + (size_t)pm * BM * (PW * 2) + C_QS * 2; u.lda = PW * 2; u.B = WBS + (size_t)pn * BM * 2048; u.ldb = 2048; u.nt = 8; }
        else { u.A = P + (size_t)pm * BM * (PW * 2) + C_QM * 2; u.lda = PW * 2; u.B = WBM + (size_t)pn * BM * 2048; u.ldb = 2048; u.nt = 8; }
        return true;
    }
};
}

namespace fa {
__device__ __forceinline__ int crow(int r, int hi) { return (r & 3) + 8 * (r >> 2) + 4 * hi; }
__device__ __forceinline__ float swap_max(float m) { auto rr = __builtin_amdgcn_permlane32_swap(__float_as_uint(m), __float_as_uint(m), false, false); return fmaxf(__uint_as_float(rr[0]), __uint_as_float(rr[1])); }
__device__ __forceinline__ float swap_add(float m) { auto rr = __builtin_amdgcn_permlane32_swap(__float_as_uint(m), __float_as_uint(m), false, false); return __uint_as_float(rr[0]) + __uint_as_float(rr[1]); }
typedef short v4i16_t __attribute__((ext_vector_type(4)));
__device__ __forceinline__ s16x4 vtr(const LAS char* p) { return __builtin_bit_cast(s16x4, __builtin_amdgcn_ds_read_tr16_b64_v4i16((LAS v4i16_t*)p)); }

constexpr int L_SLOT = 32768  , L_XCH = 0, L_WSF = 131072, L_FLG = 133120;
static_assert(4 * 128 * 33 * 4 <= L_WSF && 4 * L_SLOT <= L_WSF && L_WSF + 8 * 256 <= L_FLG && L_FLG + 64 <= LDS_BYTES - 64, "attention LDS map");

template <int DQK, int DV, int KW, int MODE>
__device__ __forceinline__ void flash_core(LAS char* lds, const bf16_t* Qw, int qpitch, const bf16_t* Kg, int kpitch, const bf16_t* Vg, int vpitch,
                                           int kstart, int t0, int nt, int koff, int qpos, float slope2, float m_init, float l_init, f32x16 (&o)[DV / 32], const int tid, const float kn = 0.f) {
    const int lane = tid & 63, r32 = lane & 31, hi = lane >> 5; const int wid = __builtin_amdgcn_readfirstlane(tid >> 6);
    constexpr int NKS = DQK / 16, NDB = DV / 32, KCH = KW / 8, VCH = DV / 8;
    constexpr int KPT = 64 * KCH / 512, VPT = 64 * VCH / 512;
    LAS float* wsf = (LAS float*)(lds + L_WSF) + wid * 64;
    bf16x8 qr[NKS];
#pragma unroll
    for (int ks = 0; ks < NKS; ++ks) qr[ks] = *(const bf16x8*)(Qw + (size_t)r32 * qpitch + ks * 16 + hi * 8);
    float qn = 0.f;
    if (MODE == 0) {
#pragma unroll
        for (int ks = 0; ks < NKS; ++ks)
#pragma unroll
            for (int j = 0; j < 8; ++j) { const float v = __uint_as_float(((unsigned)(unsigned short)qr[ks][j]) << 16); qn += v * v; }
        qn = sqrtf(swap_add(qn)) * kn;
    }
    LAS unsigned* xfl = (LAS unsigned*)(lds + L_FLG);
    const int ksw = (KW == 128) ? (r32 & 15) : ((r32 >> 1) & 7);
    int kad[NKS];
#pragma unroll
    for (int ks = 0; ks < NKS; ++ks) kad[ks] = r32 * (KW * 2) + ((((koff >> 3) + 2 * ks + hi) ^ ksw) << 4);
    const int vad = ((lane >> 4) & 1) * 32 + (lane & 3) * 8 + (4 * hi + ((lane & 15) >> 2)) * 64;
    constexpr int KPW = (64 * KW * 2 / 1024) / 8, VPW = (64 * DV * 2 / 1024) / 8;
    static_assert(KPW >= 1 && KPW <= 2 && VPW >= 1 && VPW <= 2, "pieces");
    unsigned kgoff[KPW], vgoff[VPW];
#pragma unroll
    for (int i = 0; i < KPW; ++i) { const int p = wid + 8 * i; const int row = (KW == 128) ? (4 * p + (lane >> 4)) : (8 * p + (lane >> 3)); const int slot = (KW == 128) ? (lane & 15) : (lane & 7);
        const int ch = slot ^ ((KW == 128) ? (row & 15) : ((row >> 1) & 7)); kgoff[i] = (unsigned)(row * kpitch + ch * 8) * 2u; }
#pragma unroll
    for (int i = 0; i < VPW; ++i) { const int q = wid + 8 * i; const int db = q >> 2, rg = q & 3; vgoff[i] = (unsigned)((rg * 16 + (lane >> 2)) * vpitch + db * 32 + (lane & 3) * 8) * 2u; }
#define FA_DMA(t, slot_) do { const long rb_ = (long)kstart + 64L * (t); const char* kb_ = (const char*)(Kg + rb_ * (long)kpitch); const char* vb_ = (const char*)(Vg + rb_ * (long)vpitch); \
        _Pragma("unroll") for (int i = 0; i < KPW; ++i) __builtin_amdgcn_global_load_lds((const unsigned*)(kb_ + kgoff[i]), (LAS unsigned*)(lds + (slot_) * L_SLOT + (wid + 8 * i) * 1024), 16, 0, 0); \
        _Pragma("unroll") for (int i = 0; i < VPW; ++i) __builtin_amdgcn_global_load_lds((const unsigned*)(vb_ + vgoff[i]), (LAS unsigned*)(lds + (slot_) * L_SLOT + 16384 + (wid + 8 * i) * 1024), 16, 0, 0); } while (0)
    float m = m_init, l = (hi == 0) ? l_init : 0.f;
    constexpr float THR = 8.f, SKIPT = 25.f;
    bf16x8 ke0, ke1; unsigned spk;
    { const unsigned one2 = 0x3f803f80u;
      const unsigned j0 = cvtpk((float)r32, (float)r32), j1 = cvtpk((float)(r32 + 32), (float)(r32 + 32));
      const u32x4 a0_ = (hi == 0) ? (u32x4){j0, one2, 0u, 0u} : (u32x4){0u, 0u, 0u, 0u};
      const u32x4 a1_ = (hi == 0) ? (u32x4){j1, one2, 0u, 0u} : (u32x4){0u, 0u, 0u, 0u};
      ke0 = __builtin_bit_cast(bf16x8, a0_); ke1 = __builtin_bit_cast(bf16x8, a1_);
      const float sl = (MODE != 2) ? slope2 : 0.f; const unsigned sh = cvtpk(sl, 0.f) & 0xffffu; const float shf = __uint_as_float(sh << 16);
      spk = (hi == 0) ? (sh | (cvtpk(sl - shf, 0.f) << 16)) : 0u; }
    bool mset = (m_init > -1e29f);
    if (!mset) m = 0.f;
#pragma unroll
    for (int d = 0; d < NDB; ++d)
#pragma unroll
        for (int r = 0; r < 16; ++r) o[d][r] = 0.f;
    constexpr int TPB = (MODE == 2) ? 1 : 2;
    const int nit = nt - t0;
    const int tfirst = (MODE == 0) ? (nt - 1) : t0, tstep = (MODE == 0) ? -1 : 1;
#pragma unroll
    for (int u = 0; u < TPB; ++u) if (u < nit) FA_DMA(tfirst + tstep * u, u);
    asm volatile("s_waitcnt vmcnt(0)" ::: "memory");
    __syncthreads();
    int cur = 0;
    for (int ib = 0; ib * TPB < nit; ++ib) {
#pragma unroll
        for (int u = 0; u < TPB; ++u) { const int itn = (ib + 1) * TPB + u; if (itn < nit) { if (cur) FA_DMA(tfirst + tstep * itn, u); else FA_DMA(tfirst + tstep * itn, TPB + u); } }
        const int tn = tfirst + tstep * ((ib + 1) * TPB);
#pragma unroll
        for (int u = 0; u < TPB; ++u) {
        const int it = ib * TPB + u;
        if (it < nit) {
        const int t = tfirst + tstep * it;
        const int kb = (cur ? TPB + u : u) * L_SLOT, vb = kb + 16384;
        f32x16 p0, p1;
        { const float dref = ((MODE != 2) ? slope2 * (float)(kstart + 64 * t - qpos) : 0.f) - m;
          const unsigned dh = cvtpk(dref, 0.f) & 0xffffu; const float dhf = __uint_as_float(dh << 16);
          const unsigned dpk = (hi == 0) ? (dh | (cvtpk(dref - dhf, 0.f) << 16)) : 0u;
          const u32x4 qe_ = (u32x4){spk, dpk, 0u, 0u}; const bf16x8 qe = __builtin_bit_cast(bf16x8, qe_);
          f32x16 z;
#pragma unroll
          for (int r = 0; r < 16; ++r) z[r] = 0.f;
          p0 = __builtin_amdgcn_mfma_f32_32x32x16_bf16(ke0, qe, z, 0, 0, 0);
          p1 = __builtin_amdgcn_mfma_f32_32x32x16_bf16(ke1, qe, z, 0, 0, 0); }
        { bf16x8 an0 = *(const LAS bf16x8*)(lds + kb + kad[0]), an1 = *(const LAS bf16x8*)(lds + kb + kad[0] + 32 * KW * 2);
#pragma unroll
          for (int ks = 0; ks < NKS; ++ks) {
            const bf16x8 a0 = an0, a1 = an1;
            if (ks + 1 < NKS) { an0 = *(const LAS bf16x8*)(lds + kb + kad[ks + 1 < NKS ? ks + 1 : 0]); an1 = *(const LAS bf16x8*)(lds + kb + kad[ks + 1 < NKS ? ks + 1 : 0] + 32 * KW * 2); }
            __builtin_amdgcn_sched_barrier(0);
            p0 = __builtin_amdgcn_mfma_f32_32x32x16_bf16(a0, qr[ks], p0, 0, 0, 0);
            p1 = __builtin_amdgcn_mfma_f32_32x32x16_bf16(a1, qr[ks], p1, 0, 0, 0);
            __builtin_amdgcn_sched_barrier(0);
          } }
        if (MODE != 2) {
            if (MODE == 1 || t >= nt - 2) {
                const int dq = qpos - (kstart + 64 * t + 4 * hi);
#pragma unroll
                for (int r = 0; r < 16; ++r) { const int c = (r & 3) + 8 * (r >> 2); const int d0 = dq - c, d1 = dq - c - 32;
                    const bool ok0 = (MODE == 1) ? (d0 >= 0 && d0 < 128) : (d0 >= 0), ok1 = (MODE == 1) ? (d1 >= 0 && d1 < 128) : (d1 >= 0);
                    if (!ok0) p0[r] = -INFINITY; if (!ok1) p1[r] = -INFINITY; }
            }
        }
        float r0 = p0[0], r1 = p1[0];
#pragma unroll
        for (int r = 1; r < 16; ++r) { r0 = fmaxf(r0, p0[r]); r1 = fmaxf(r1, p1[r]); }
        const float rm = swap_max(fmaxf(r0, r1));
        const bool valid = rm > -1e37f;
        float dl = 0.f;
        if (__any(valid && (!mset || rm > THR))) {
            dl = valid ? (mset ? fmaxf(rm, 0.f) : rm) : 0.f;
            const float alpha = mset ? ex2(-dl) : 1.f;
            m += dl; l *= alpha; mset = mset || valid;
#pragma unroll
            for (int r = 0; r < 16; ++r) { p0[r] -= dl; p1[r] -= dl; }
            asm volatile("" ::: "memory");
            if (hi == 0) wsf[r32] = alpha;
            asm volatile("s_waitcnt lgkmcnt(0)" ::: "memory");
#pragma unroll
            for (int r = 0; r < 16; ++r) { const float al = wsf[crow(r, hi)];
#pragma unroll
                for (int d = 0; d < NDB; ++d) o[d][r] *= al; }
            asm volatile("" ::: "memory");
        }
        const float rmn = valid ? rm - dl : -INFINITY;
        const bool skip = (MODE == 0) && __all(rmn < -SKIPT && (mset || !valid));
        if (!skip) {
        float sacc = 0.f;
#pragma unroll
        for (int r = 0; r < 16; ++r) { p0[r] = ex2(p0[r]); p1[r] = ex2(p1[r]); sacc += p0[r] + p1[r]; }
        l += sacc;
        u32x4 pw[4];
        pw[0] = (u32x4){cvtpk(p0[0], p0[1]), cvtpk(p0[2], p0[3]), cvtpk(p0[4], p0[5]), cvtpk(p0[6], p0[7])};
        pw[1] = (u32x4){cvtpk(p0[8], p0[9]), cvtpk(p0[10], p0[11]), cvtpk(p0[12], p0[13]), cvtpk(p0[14], p0[15])};
        pw[2] = (u32x4){cvtpk(p1[0], p1[1]), cvtpk(p1[2], p1[3]), cvtpk(p1[4], p1[5]), cvtpk(p1[6], p1[7])};
        pw[3] = (u32x4){cvtpk(p1[8], p1[9]), cvtpk(p1[10], p1[11]), cvtpk(p1[12], p1[13]), cvtpk(p1[14], p1[15])};
        const LAS char* vp = (const LAS char*)(lds + vb + vad);
        { constexpr int NF = NDB * 4;
          s16x4 flo[3], fhi[3];
#define FA_VRD(i_, slot_) do { flo[slot_] = vtr(vp + ((i_) >> 2) * 4096 + ((i_) & 3) * 1024); fhi[slot_] = vtr(vp + ((i_) >> 2) * 4096 + ((i_) & 3) * 1024 + 512); } while (0)
          FA_VRD(0, 0); FA_VRD(1, 1);
#pragma unroll
          for (int i = 0; i < NF; ++i) {
            if (i + 2 < NF) FA_VRD(i + 2 < NF ? i + 2 : 0, (i + 2) % 3);
            __builtin_amdgcn_sched_barrier(0);
            const s16x4 lo = flo[i % 3], hh = fhi[i % 3];
            const bf16x8 vf = (bf16x8){lo[0], lo[1], lo[2], lo[3], hh[0], hh[1], hh[2], hh[3]};
            o[i >> 2] = __builtin_amdgcn_mfma_f32_32x32x16_bf16(__builtin_bit_cast(bf16x8, pw[i & 3]), vf, o[i >> 2], 0, 0, 0);
            __builtin_amdgcn_sched_barrier(0);
          }
#undef FA_VRD
        }
        }
        }
        }
        if (MODE == 0) {
            const bool done = __all(mset && (qn + slope2 * (float)(64 * tn + 63 - qpos) - m < -SKIPT));
            if (lane == 0) xfl[(ib & 1) * 8 + wid] = done ? 1u : 0u;
        }
        asm volatile("s_waitcnt vmcnt(0)" ::: "memory");
        __syncthreads();
        cur ^= 1;
        if (MODE == 0) {
            const LAS unsigned* f = xfl + (ib & 1) * 8;
            const unsigned all = (f[0] & f[1]) & (f[2] & f[3]) & (f[4] & f[5]) & (f[6] & f[7]);
            if (__builtin_amdgcn_readfirstlane(all)) break;
        }
    }
#undef FA_DMA
    l = swap_add(l);
    const float inv = 1.f / l;
    asm volatile("" ::: "memory");
    if (hi == 0) wsf[r32] = inv;
    asm volatile("s_waitcnt lgkmcnt(0)" ::: "memory");
#pragma unroll
    for (int r = 0; r < 16; ++r) { const float a = wsf[crow(r, hi)];
#pragma unroll
        for (int d = 0; d < NDB; ++d) o[d][r] *= a; }
    asm volatile("" ::: "memory");
}

template <int NDB>
__device__ __forceinline__ void store_o(bf16_t* Ow, int opitch, const f32x16 (&o)[NDB], int r32, int hi, int dry) {
    if (dry) return;
#pragma unroll
    for (int r = 0; r < 16; ++r) { bf16_t* p = Ow + (size_t)crow(r, hi) * opitch + r32;
#pragma unroll
        for (int d = 0; d < NDB; ++d) p[d * 32] = (bf16_t)(cvtpk(o[d][r], 0.f) & 0xffffu); }
}
}


#define XB_TMO      128
#define XB_XCNT(j)  (256  + 64 * (j))
#define XB_XSUB(j)  (1280 + 64 * (j))
#define XB_XGEN(j)  (2304 + 64 * (j))
#define XB_TOP      3328
#define XB_TOPGEN   3392
#define XCD_BAR_WORDS 3456
#define XB_SPIN_CAP (1u << 18)
__device__ __forceinline__ unsigned xb_ld(unsigned* p)              { return __hip_atomic_load(p, __ATOMIC_RELAXED, __HIP_MEMORY_SCOPE_AGENT); }
__device__ __forceinline__ unsigned xb_add(unsigned* p, unsigned v) { return __hip_atomic_fetch_add(p, v, __ATOMIC_RELAXED, __HIP_MEMORY_SCOPE_AGENT); }
__device__ __forceinline__ unsigned xb_xcc_id() { return (unsigned)__builtin_amdgcn_s_getreg((3 << 11) | 20) & 0xFu; }
#define XB_SPIN(cond, bar) do { unsigned _sp = 0; while (cond) { __builtin_amdgcn_s_sleep(1); \
    if ((++_sp & 255u) == 0u) { if (xb_ld(&(bar)[XB_TMO])) break; if (_sp > XB_SPIN_CAP) { atomicAdd(&(bar)[XB_TMO], 1u); break; } } } } while (0)
struct XcdBarrier { unsigned* bar; unsigned x; volatile LAS unsigned* st; };
__device__ __forceinline__ XcdBarrier xcd_barrier_post(unsigned* bar, volatile LAS unsigned* st) {
    XcdBarrier b; b.bar = bar; b.x = xb_xcc_id(); b.st = st;
    if (threadIdx.x == 0) (void)xb_add(&bar[XB_XCNT(b.x)], 1u);
    return b;
}
__device__ __forceinline__ void xcd_barrier_complete(unsigned* bar, unsigned x, unsigned& nloc, unsigned& nx) {
    const unsigned G = gridDim.x * gridDim.y * gridDim.z;
    unsigned sum, cnt, mine, sp = 0u;
    for (;;) {
        sum = 0u; cnt = 0u; mine = 0u;
#pragma unroll
        for (unsigned j = 0; j < 16; ++j) { const unsigned c = xb_ld(&bar[XB_XCNT(j)]); sum += c; cnt += (c > 0u) ? 1u : 0u; mine = (j == x) ? c : mine; }
        if (sum == G) break;
        __builtin_amdgcn_s_sleep(1);
        if ((++sp & 255u) == 0u) { if (xb_ld(&bar[XB_TMO])) break; if (sp > XB_SPIN_CAP) { atomicAdd(&bar[XB_TMO], 1u); break; } }
    }
    nloc = mine > 0u ? mine : 1u; nx = cnt > 0u ? cnt : 1u;
}
__device__ __forceinline__ void xcd_barrier(const XcdBarrier& b) {
    asm volatile("s_waitcnt vmcnt(0)" ::: "memory");
    __syncthreads();
    if (threadIdx.x == 0) {
        unsigned* bar = b.bar;
        __builtin_amdgcn_s_waitcnt(0);
        unsigned nloc = b.st[0], nx = b.st[1];
        if (nloc == 0u) { xcd_barrier_complete(bar, b.x, nloc, nx); b.st[0] = nloc; b.st[1] = nx; }
        const unsigned old = xb_add(&bar[XB_XSUB(b.x)], 1u);
        const unsigned gen = old / nloc;
        if (old + 1u == (gen + 1u) * nloc) {
            __builtin_amdgcn_fence(__ATOMIC_RELEASE, "agent");
            asm volatile("s_waitcnt vmcnt(0)" ::: "memory");
            const unsigned og = xb_add(&bar[XB_TOP], 1u);
            const unsigned tg = og / nx;
            if (og + 1u == (tg + 1u) * nx) xb_add(&bar[XB_TOPGEN], 1u);
            else XB_SPIN(xb_ld(&bar[XB_TOPGEN]) == tg, bar);
            __builtin_amdgcn_fence(__ATOMIC_ACQUIRE, "agent");
            xb_add(&bar[XB_XGEN(b.x)], 1u);
            asm volatile("s_waitcnt vmcnt(0)" ::: "memory");
        } else {
            XB_SPIN(xb_ld(&bar[XB_XGEN(b.x)]) == gen, bar);
            __builtin_amdgcn_fence(__ATOMIC_ACQUIRE, "agent");
            asm volatile("s_waitcnt vmcnt(0)" ::: "memory");
        }
    }
    __syncthreads();
}

struct Args { const float* in[20]; float* out; unsigned char* ws; int ph_lo, ph_hi; };
static_assert(sizeof(Args) == 22 * 8 + 8, "Args has no padding");

template <bool SWIGLU>
__device__ __forceinline__ void conv_item(const float* W, int Nsrc, int src_base, bf16_t* WT, int Kpitch, int nb, int kb, const float* gain, int lane) {
    const int nd = nb * 256 + 4 * lane;
    int sc;
    if (SWIGLU) { const int cc = 4 * lane; sc = (cc < 128) ? (nb * 128 + cc) : (FF + nb * 128 + cc - 128); } else sc = src_base + nd;
    const float* src = W + (size_t)(kb * 64) * Nsrc + sc;
    bf16_t* dst = WT + (size_t)nd * Kpitch + kb * 64;
#pragma unroll 4
    for (int c = 0; c < 8; ++c) {
        f32x4 v[8];
#pragma unroll
        for (int j = 0; j < 8; ++j) v[j] = *(const f32x4*)(src + (size_t)(c * 8 + j) * Nsrc);
        if (gain) {
#pragma unroll
            for (int j = 0; j < 8; ++j) v[j] = v[j] * gain[kb * 64 + c * 8 + j];
        }
#pragma unroll
        for (int i = 0; i < 4; ++i) { u32x4 o; o.x = cvtpk(v[0][i], v[1][i]); o.y = cvtpk(v[2][i], v[3][i]); o.z = cvtpk(v[4][i], v[5][i]); o.w = cvtpk(v[6][i], v[7][i]);
            *(u32x4*)(dst + (size_t)i * Kpitch + c * 8) = o; }
    }
}

__device__ __forceinline__ void convert_weights(const Args& a, unsigned char* ws, int l, LAS unsigned char* lds, int gw, int NGW, int wave, int lane) {
    const float* ffn1_wi = a.in[3] + (size_t)l * DM * 2 * FF; const float* ffn1_wo = a.in[4] + (size_t)l * FF * DM; const float* w_in = a.in[6] + (size_t)l * DM * INW;
    const float* w_mkv = a.in[11] + (size_t)l * DM * DM; const float* w_bd = a.in[12] + (size_t)l * DM * DM; const float* w_bs = a.in[13] + (size_t)l * 512 * DM;
    const float* w_bm = a.in[14] + (size_t)l * 512 * DM; const float* w_out = a.in[15] + (size_t)l * DM * DM; const float* ffn2_wi = a.in[17] + (size_t)l * DM * 2 * FF; const float* ffn2_wo = a.in[18] + (size_t)l * FF * DM;
    const float* g_ffn1 = a.in[2] + l * DM; const float* g_mix = a.in[5] + l * DM; const float* g_mem = a.in[10] + l * DM; const float* g_ffn2 = a.in[16] + l * DM;
    constexpr int I_WI = 22 * 16, I_WO = 4 * 44, I_IN = 17 * 16, I_G = 12 * 16, I_SQ = 4 * 16, I_BS = 4 * 8;
    constexpr int NITEMS = 2 * I_WI + 2 * I_WO + I_IN + I_G + 3 * I_SQ + 2 * I_BS;
    for (int it = gw; it < NITEMS; it += NGW) {
        int r = it;
        if (r < 2 * I_WI) { const bool second = r >= I_WI; if (second) r -= I_WI; const int kb = r / 22, nb = r % 22;
            conv_item<true>(second ? ffn2_wi : ffn1_wi, 2 * FF, 0, (bf16_t*)(ws + (second ? W_FFN2I : W_FFN1I)), DM, nb, kb, second ? g_ffn2 : g_ffn1, lane); continue; }
        r -= 2 * I_WI;
        if (r < 2 * I_WO) { const bool second = r >= I_WO; if (second) r -= I_WO; const int kb = r / 4, nb = r % 4;
            conv_item<false>(second ? ffn2_wo : ffn1_wo, DM, 0, (bf16_t*)(ws + (second ? W_FFN2O : W_FFN1O)), FF, nb, kb, nullptr, lane); continue; }
        r -= 2 * I_WO;
        if (r < I_IN) { const int kb = r / 17, nb = r % 17; conv_item<false>(w_in, INW, 0, (bf16_t*)(ws + W_IN), DM, nb, kb, g_mix, lane); continue; }
        r -= I_IN;
        if (r < I_G) { const int kb = r / 12, nb = r % 12; conv_item<false>(w_in, INW, PW, (bf16_t*)(ws + W_G), DM, nb, kb, g_mix, lane); continue; }
        r -= I_G;
        if (r < 3 * I_SQ) { const int which = r / I_SQ; r -= which * I_SQ; const int kb = r / 4, nb = r % 4;
            const float* src = which == 0 ? w_mkv : which == 1 ? w_bd : w_out; const size_t dst = which == 0 ? W_MKV : which == 1 ? W_BRD : W_OUT;
            conv_item<false>(src, DM, 0, (bf16_t*)(ws + dst), DM, nb, kb, which == 0 ? g_mem : nullptr, lane); continue; }
        r -= 3 * I_SQ;
        { const bool second = r >= I_BS; if (second) r -= I_BS; const int kb = r / 4, nb = r % 4;
            conv_item<false>(second ? w_bm : w_bs, DM, 0, (bf16_t*)(ws + (second ? W_BRM : W_BRS)), 1024, nb, kb, nullptr, lane); }
    }
}

__device__ __forceinline__ void rms_row_bf16(const float* xrow, bf16_t* orow, int lane) {
    const f32x4* xr = (const f32x4*)xrow + lane;
    f32x4 v[4]; float s = 0.f;
#pragma unroll
    for (int j = 0; j < 4; ++j) { v[j] = xr[64 * j]; s += (v[j].x * v[j].x + v[j].y * v[j].y) + (v[j].z * v[j].z + v[j].w * v[j].w); }
    const float rstd = 1.0f / sqrtf(wave_sum(s) * (1.f / DM) + EPS);
    u32x2* o8 = (u32x2*)orow + lane;
#pragma unroll
    for (int j = 0; j < 4; ++j) { u32x2 w; w.x = cvtpk(v[j].x * rstd, v[j].y * rstd); w.y = cvtpk(v[j].z * rstd, v[j].w * rstd); o8[64 * j] = w; }
}
__device__ __forceinline__ void rms_row2_bf16(const float* xrow, bf16_t* orow, size_t stride, int lane) {
    const f32x4* xa = (const f32x4*)xrow + lane; const f32x4* xb = (const f32x4*)(xrow + stride) + lane;
    f32x4 va[4], vb[4]; float sa = 0.f, sb = 0.f;
#pragma unroll
    for (int j = 0; j < 4; ++j) { va[j] = xa[64 * j]; vb[j] = xb[64 * j]; }
#pragma unroll
    for (int j = 0; j < 4; ++j) { sa += (va[j].x * va[j].x + va[j].y * va[j].y) + (va[j].z * va[j].z + va[j].w * va[j].w); sb += (vb[j].x * vb[j].x + vb[j].y * vb[j].y) + (vb[j].z * vb[j].z + vb[j].w * vb[j].w); }
    const float ra = 1.0f / sqrtf(wave_sum(sa) * (1.f / DM) + EPS), rb = 1.0f / sqrtf(wave_sum(sb) * (1.f / DM) + EPS);
    u32x2* oa = (u32x2*)orow + lane; u32x2* ob = (u32x2*)(orow + stride) + lane;
#pragma unroll
    for (int j = 0; j < 4; ++j) { u32x2 w; w.x = cvtpk(va[j].x * ra, va[j].y * ra); w.y = cvtpk(va[j].z * ra, va[j].w * ra); oa[64 * j] = w;
        u32x2 w2; w2.x = cvtpk(vb[j].x * rb, vb[j].y * rb); w2.y = cvtpk(vb[j].z * rb, vb[j].w * rb); ob[64 * j] = w2; }
}
__device__ __forceinline__ void rms_row2_b16(const bf16_t* srow, bf16_t* orow, size_t stride, int lane) {
    const u32x4* xa = (const u32x4*)srow + lane; const u32x4* xb = (const u32x4*)(srow + stride) + lane;
    u32x4 va[2], vb[2]; float sa = 0.f, sb = 0.f;
#pragma unroll
    for (int j = 0; j < 2; ++j) { va[j] = xa[64 * j]; vb[j] = xb[64 * j]; }
    float fa[16], fb[16];
#pragma unroll
    for (int j = 0; j < 2; ++j) { fa[8*j] = bf_lo(va[j].x); fa[8*j+1] = bf_hi(va[j].x); fa[8*j+2] = bf_lo(va[j].y); fa[8*j+3] = bf_hi(va[j].y); fa[8*j+4] = bf_lo(va[j].z); fa[8*j+5] = bf_hi(va[j].z); fa[8*j+6] = bf_lo(va[j].w); fa[8*j+7] = bf_hi(va[j].w);
        fb[8*j] = bf_lo(vb[j].x); fb[8*j+1] = bf_hi(vb[j].x); fb[8*j+2] = bf_lo(vb[j].y); fb[8*j+3] = bf_hi(vb[j].y); fb[8*j+4] = bf_lo(vb[j].z); fb[8*j+5] = bf_hi(vb[j].z); fb[8*j+6] = bf_lo(vb[j].w); fb[8*j+7] = bf_hi(vb[j].w); }
#pragma unroll
    for (int i = 0; i < 16; ++i) { sa += fa[i] * fa[i]; sb += fb[i] * fb[i]; }
    const float ra = 1.0f / sqrtf(wave_sum(sa) * (1.f / DM) + EPS), rb = 1.0f / sqrtf(wave_sum(sb) * (1.f / DM) + EPS);
    u32x4* oa = (u32x4*)orow + lane; u32x4* ob = (u32x4*)(orow + stride) + lane;
#pragma unroll
    for (int j = 0; j < 2; ++j) { u32x4 w; w.x = cvtpk(fa[8*j] * ra, fa[8*j+1] * ra); w.y = cvtpk(fa[8*j+2] * ra, fa[8*j+3] * ra); w.z = cvtpk(fa[8*j+4] * ra, fa[8*j+5] * ra); w.w = cvtpk(fa[8*j+6] * ra, fa[8*j+7] * ra); oa[64 * j] = w;
        u32x4 w2; w2.x = cvtpk(fb[8*j] * rb, fb[8*j+1] * rb); w2.y = cvtpk(fb[8*j+2] * rb, fb[8*j+3] * rb); w2.z = cvtpk(fb[8*j+4] * rb, fb[8*j+5] * rb); w2.w = cvtpk(fb[8*j+6] * rb, fb[8*j+7] * rb); ob[64 * j] = w2; }
}
__device__ __forceinline__ void rms_row_b16_f32(const bf16_t* srow, float* orow, const float* g, int lane) {
    const u32x4* xa = (const u32x4*)srow + lane; u32x4 va[2]; float s = 0.f; float f[16];
#pragma unroll
    for (int j = 0; j < 2; ++j) va[j] = xa[64 * j];
#pragma unroll
    for (int j = 0; j < 2; ++j) { f[8*j] = bf_lo(va[j].x); f[8*j+1] = bf_hi(va[j].x); f[8*j+2] = bf_lo(va[j].y); f[8*j+3] = bf_hi(va[j].y); f[8*j+4] = bf_lo(va[j].z); f[8*j+5] = bf_hi(va[j].z); f[8*j+6] = bf_lo(va[j].w); f[8*j+7] = bf_hi(va[j].w); }
#pragma unroll
    for (int i = 0; i < 16; ++i) s += f[i] * f[i];
    const float rstd = 1.0f / sqrtf(wave_sum(s) * (1.f / DM) + EPS);
#pragma unroll
    for (int j = 0; j < 2; ++j) { const f32x4* gp = (const f32x4*)(g + 512 * j + 8 * lane); f32x4* op = (f32x4*)(orow + 512 * j + 8 * lane);
        const f32x4 g0 = gp[0], g1 = gp[1];
        op[0] = (f32x4){f[8*j] * rstd * g0[0], f[8*j+1] * rstd * g0[1], f[8*j+2] * rstd * g0[2], f[8*j+3] * rstd * g0[3]};
        op[1] = (f32x4){f[8*j+4] * rstd * g1[0], f[8*j+5] * rstd * g1[1], f[8*j+6] * rstd * g1[2], f[8*j+7] * rstd * g1[3]}; }
}
__device__ __forceinline__ void raw_row2_bf16(const float* xrow, bf16_t* orow, float* ssq4, size_t stride, size_t sstride, int lane) {
    const f32x4* xa = (const f32x4*)xrow + lane; const f32x4* xb = (const f32x4*)(xrow + stride) + lane;
    f32x4 va[4], vb[4]; float sa = 0.f, sb = 0.f;
#pragma unroll
    for (int j = 0; j < 4; ++j) { va[j] = xa[64 * j]; vb[j] = xb[64 * j]; }
#pragma unroll
    for (int j = 0; j < 4; ++j) { sa += (va[j].x * va[j].x + va[j].y * va[j].y) + (va[j].z * va[j].z + va[j].w * va[j].w); sb += (vb[j].x * vb[j].x + vb[j].y * vb[j].y) + (vb[j].z * vb[j].z + vb[j].w * vb[j].w); }
    sa = wave_sum(sa); sb = wave_sum(sb);
    u32x2* oa = (u32x2*)orow + lane; u32x2* ob = (u32x2*)(orow + stride) + lane;
#pragma unroll
    for (int j = 0; j < 4; ++j) { u32x2 w; w.x = cvtpk(va[j].x, va[j].y); w.y = cvtpk(va[j].z, va[j].w); oa[64 * j] = w;
        u32x2 w2; w2.x = cvtpk(vb[j].x, vb[j].y); w2.y = cvtpk(vb[j].z, vb[j].w); ob[64 * j] = w2; }
    if (lane == 0) { *(f32x4*)ssq4 = (f32x4){sa, 0.f, 0.f, 0.f}; *(f32x4*)(ssq4 + sstride) = (f32x4){sb, 0.f, 0.f, 0.f}; }
}
__device__ __forceinline__ void rms_row4_b16_f32(const bf16_t* srow, float* orow, size_t stride, const float* g, int lane) {
    u32x4 v[4][2];
#pragma unroll
    for (int r = 0; r < 4; ++r)
#pragma unroll
        for (int j = 0; j < 2; ++j) v[r][j] = ((const u32x4*)(srow + r * stride) + lane)[64 * j];
    f32x4 gg[2][2];
#pragma unroll
    for (int j = 0; j < 2; ++j) { const f32x4* gp = (const f32x4*)(g + 512 * j + 8 * lane); gg[j][0] = gp[0]; gg[j][1] = gp[1]; }
#pragma unroll
    for (int r = 0; r < 4; ++r) {
        float f[16]; float s = 0.f;
#pragma unroll
        for (int j = 0; j < 2; ++j) { const u32x4 w = v[r][j]; f[8*j] = bf_lo(w.x); f[8*j+1] = bf_hi(w.x); f[8*j+2] = bf_lo(w.y); f[8*j+3] = bf_hi(w.y); f[8*j+4] = bf_lo(w.z); f[8*j+5] = bf_hi(w.z); f[8*j+6] = bf_lo(w.w); f[8*j+7] = bf_hi(w.w); }
#pragma unroll
        for (int i = 0; i < 16; ++i) s += f[i] * f[i];
        const float rstd = 1.0f / sqrtf(wave_sum(s) * (1.f / DM) + EPS);
#pragma unroll
        for (int j = 0; j < 2; ++j) { f32x4* op = (f32x4*)(orow + r * stride + 512 * j + 8 * lane);
            op[0] = (f32x4){f[8*j] * rstd * gg[j][0][0], f[8*j+1] * rstd * gg[j][0][1], f[8*j+2] * rstd * gg[j][0][2], f[8*j+3] * rstd * gg[j][0][3]};
            op[1] = (f32x4){f[8*j+4] * rstd * gg[j][1][0], f[8*j+5] * rstd * gg[j][1][1], f[8*j+6] * rstd * gg[j][1][2], f[8*j+7] * rstd * gg[j][1][3]}; }
    }
}
__device__ __forceinline__ void rms_row_f32(const float* xrow, float* orow, const float* g, int lane) {
    const f32x4* xr = (const f32x4*)xrow + lane; const f32x4* gr = (const f32x4*)g + lane;
    f32x4 v[4]; float s = 0.f;
#pragma unroll
    for (int j = 0; j < 4; ++j) { v[j] = xr[64 * j]; s += (v[j].x * v[j].x + v[j].y * v[j].y) + (v[j].z * v[j].z + v[j].w * v[j].w); }
    const float rstd = 1.0f / sqrtf(wave_sum(s) * (1.f / DM) + EPS);
    f32x4* o = (f32x4*)orow + lane;
#pragma unroll
    for (int j = 0; j < 4; ++j) o[64 * j] = v[j] * rstd * gr[64 * j];
}

constexpr int FA_NMAX = 8;
__device__ const unsigned char fa_cnt[32] = {8, 8, 8, 8, 8, 8, 8, 8, 8, 8, 8, 8, 8, 8, 8, 8, 8, 8, 8, 8, 8, 8, 8, 8, 8, 8, 8, 8, 8, 8, 8, 8};
__device__ const unsigned char fa_tab[32][FA_NMAX] = {
    {255, 171, 161, 136, 111, 89, 52, 16},
    {234, 223, 139, 129, 110, 88, 51, 15},
    {254, 235, 138, 109, 97, 87, 50, 14},
    {222, 203, 137, 108, 86, 65, 49, 13},
    {253, 232, 204, 162, 120, 82, 48, 12},
    {221, 200, 172, 130, 119, 81, 47, 11},
    {252, 173, 168, 118, 98, 80, 46, 10},
    {236, 220, 145, 117, 95, 79, 45, 9},
    {251, 237, 144, 116, 94, 78, 44, 8},
    {219, 205, 143, 115, 93, 77, 43, 7},
    {250, 206, 142, 114, 92, 76, 42, 6},
    {218, 174, 141, 113, 91, 75, 41, 5},
    {249, 175, 140, 112, 90, 74, 40, 4},
    {238, 217, 195, 151, 126, 73, 39, 3},
    {248, 239, 163, 150, 125, 72, 38, 2},
    {216, 207, 149, 131, 124, 71, 37, 1},
    {247, 224, 208, 148, 123, 99, 70, 36},
    {226, 215, 176, 147, 122, 85, 57, 24},
    {246, 194, 177, 146, 121, 84, 56, 23},
    {240, 229, 214, 192, 156, 106, 63, 35},
    {245, 241, 197, 160, 155, 105, 62, 34},
    {213, 209, 165, 154, 128, 104, 61, 33},
    {244, 179, 153, 133, 103, 60, 31, 22},
    {212, 178, 152, 127, 107, 96, 69, 28},
    {243, 230, 181, 158, 102, 59, 30, 21},
    {211, 198, 180, 157, 101, 58, 29, 20},
    {242, 228, 202, 187, 166, 68, 64, 27},
    {210, 196, 186, 170, 134, 67, 32, 26},
    {233, 231, 191, 185, 164, 66, 25, 0},
    {225, 201, 199, 190, 184, 132, 55, 19},
    {193, 189, 183, 169, 167, 100, 54, 18},
    {227, 188, 182, 159, 135, 83, 53, 17}
};
__device__ __forceinline__ void attention_phase(const Args& a, unsigned char* ws, int l, LAS unsigned char* ldsu, int vcu0, int G, const int tid, const int dry) {
    LAS char* lds = (LAS char*)ldsu;
    const int lane = tid & 63, r32 = lane & 31, hi = lane >> 5; const int wid = __builtin_amdgcn_readfirstlane(tid >> 6);
    bf16_t* P = (bf16_t*)(ws + WS_P); const bf16_t* MKV = (const bf16_t*)(ws + WS_MKV);
    const float linit = 0.8f - 0.6f * expf(-0.3f * (float)l);
    float lam;
    { const float* lp = a.in[7] + l * 256; const float s1 = wave_sum(lp[lane] * lp[64 + lane]), s2 = wave_sum(lp[128 + lane] * lp[192 + lane]); lam = expf(s1) - expf(s2) + linit; }
    const float* gsub = a.in[8] + l * 128; const float* sinks = a.in[9] + l * 8;
    for (int vcu = vcu0; vcu < 256; vcu += G) {
        if (!(dry && !(PROBE_SUB & 1))) {
            const int b = vcu >> 5, j = vcu & 31;
            const int map = wid >> 2, w = wid & 3;
            const int nun = fa_cnt[j];
            for (int ui = 0; ui < nun; ++ui) {
                const int code_ = fa_tab[j][ui]; const int h = code_ >> 5, qb = code_ & 31;
                const float slope2 = exp2f(-(float)(h + 1)) * LOG2E;
                float gs[4];
#pragma unroll
                for (int d = 0; d < 4; ++d) gs[d] = gsub[d * 32 + r32] * (1.f - linit);
                const int q0 = qb * 128; const size_t rowb = (size_t)b * SEQ;
                const bf16_t* Qw = P + (rowb + q0 + 32 * w) * PW + C_QD + h * 128 + map * 64;
                const bf16_t* Kg = P + rowb * PW + C_KD + h * 128; const bf16_t* Vg = P + rowb * PW + C_VD + h * 128;
                f32x16 o[4];
                const unsigned* knp = (const unsigned*)(ws + WS_KNP) + l * 256 + ((b * 8 + h) * 2 + map) * 2;
                const float kn = sqrtf((__uint_as_float(knp[0]) + __uint_as_float(knp[1])) * 1.03f);
                fa::flash_core<64, 128, 128, 0>(lds, Qw, PW, Kg, PW, Vg, PW, 0, 0, 2 * qb + 2, map * 64, q0 + 32 * w + r32, slope2, -1e30f, 0.f, o, tid, kn);
                LAS float* X = (LAS float*)(lds + fa::L_XCH);
                if (map == 1) {
#pragma unroll
                    for (int d = 0; d < 4; ++d)
#pragma unroll
                        for (int r = 0; r < 16; ++r) X[(w * 128 + d * 32 + r32) * 33 + fa::crow(r, hi)] = o[d][r];
                }
                __syncthreads();
                if (map == 0) {
                    float ss[16];
#pragma unroll
                    for (int r = 0; r < 16; ++r) { float q = 0.f;
#pragma unroll
                        for (int d = 0; d < 4; ++d) { const float v = o[d][r] - lam * X[(w * 128 + d * 32 + r32) * 33 + fa::crow(r, hi)]; o[d][r] = v; q += v * v; }
                        ss[r] = q; }
#pragma unroll
                    for (int r = 0; r < 16; ++r) { float q = ss[r]; q += __shfl_xor(q, 1); q += __shfl_xor(q, 2); q += __shfl_xor(q, 4); q += __shfl_xor(q, 8); q += __shfl_xor(q, 16);
                        const float rstd = 1.0f / sqrtf(q * (1.f / 128.f) + EPS);
#pragma unroll
                        for (int d = 0; d < 4; ++d) o[d][r] *= rstd * gs[d]; }
                    fa::store_o<4>(P + (rowb + q0 + 32 * w) * PW + C_QD + h * 128, PW, o, r32, hi, dry);
                }
                __syncthreads();
            }
        }
        if (!(dry && !(PROBE_SUB & 2))) for (int i = 0; i < 4; ++i) {
            const int id = vcu * 4 + i, qblk = id & 63, kvh = (id >> 6) & 1, b = id >> 7;
            const int g = wid >> 1, rg = wid & 1, head = kvh * 4 + g;
            const int q0 = qblk * 64; const size_t rowb = (size_t)b * SEQ;
            const int kstart = q0 - 128, t0 = kstart < 0 ? (-kstart) / 64 : 0;
            const float slope2 = exp2f(-(float)(head + 1)) * LOG2E;
            const bf16_t* Qw = P + (rowb + q0 + 32 * rg) * PW + C_QS + head * 64;
            const bf16_t* Kg = P + rowb * PW + C_KS + kvh * 64; const bf16_t* Vg = P + rowb * PW + C_VS + kvh * 64;
            f32x16 o[2];
            fa::flash_core<64, 64, 64, 1>(lds, Qw, PW, Kg, PW, Vg, PW, kstart, t0, 3, 0, q0 + 32 * rg + r32, slope2, sinks[head] * LOG2E, 1.f, o, tid);
            fa::store_o<2>(P + (rowb + q0 + 32 * rg) * PW + C_QS + head * 64, PW, o, r32, hi, dry);
        }
        if (!(dry && !(PROBE_SUB & 4))) for (int i = 0; i < 2; ++i) {
            const int id = vcu * 2 + i, qblk = id & 15, mh = (id >> 4) & 3, b = id >> 6;
            const size_t rowb = (size_t)b * SEQ + qblk * 256 + 32 * wid;
            const bf16_t* Qw = P + rowb * PW + C_QM + mh * 128;
            const bf16_t* Kg = MKV + (size_t)b * MEMLEN * DM + mh * 128; const bf16_t* Vg = Kg + 512;
            f32x16 o[4];
            fa::flash_core<128, 128, 128, 2>(lds, Qw, PW, Kg, DM, Vg, DM, 0, 0, 4, 0, 0, 0.f, -1e30f, 0.f, o, tid);
            fa::store_o<4>(P + rowb * PW + C_QM + mh * 128, PW, o, r32, hi, dry);
        }
    }
}

__global__ void __launch_bounds__(NWAVES * 64, 2) mega_fwd(Args args) {
    extern __shared__ __attribute__((aligned(16))) unsigned char lds_raw[];
    LAS unsigned char* lds = (LAS unsigned char*)lds_raw;
    const int G = gridDim.x, bx = blockIdx.x;
    const int vcu = (G % 8 == 0) ? (bx % 8) * (G / 8) + bx / 8 : bx;
    const int NGW = G * NWAVES;
    const int lo = args.ph_lo, hi = args.ph_hi;
    volatile LAS unsigned* bst = (volatile LAS unsigned*)(lds + LDS_BYTES - 64);
    if (threadIdx.x < 2) bst[threadIdx.x] = 0u;
    __syncthreads();
    XcdBarrier bar = xcd_barrier_post((unsigned*)args.ws, bst);
    int second = 0;
    for (int p = lo; p < hi;) {
        if (p > lo) { if (hi > 1000000) cg::this_grid().sync(); xcd_barrier(bar); }
        int tid = threadIdx.x; asm volatile("" : "+v"(tid));
        unsigned char* ws = args.ws; asm volatile("" : "+s"(ws));
        const int lane = tid & 63; const int wave = __builtin_amdgcn_readfirstlane(tid >> 6);
        const int gw = vcu * NWAVES + wave;
        bf16_t* XN = (bf16_t*)(ws + WS_XN); bf16_t* MN = (bf16_t*)(ws + WS_MN); bf16_t* MKV = (bf16_t*)(ws + WS_MKV); bf16_t* P = (bf16_t*)(ws + WS_P); bf16_t* ACT = P; bf16_t* MRG = (bf16_t*)(ws + WS_MRG);
        unsigned char* const wsw1 = ws + (WS_XN - WS_W);
        if (p == 0) {
            convert_weights(args, ws, 0, lds, gw, NGW, wave, lane);
            convert_weights(args, wsw1, 1, lds, gw, NGW, wave, lane);
            for (int m = gw; m < M; m += 2 * NGW) raw_row2_bf16(args.in[0] + (size_t)m * DM, (bf16_t*)args.out + (size_t)m * DM, (float*)(ws + WS_SSQ) + (size_t)m * 4, (size_t)NGW * DM, (size_t)NGW * 4, lane);
            for (int m = gw; m < MR; m += NGW) rms_row_bf16(args.in[1] + (size_t)m * DM, MN + (size_t)m * DM, lane);
            __syncthreads();
            ++p; second = 0; continue;
        }
        if (p == N_PHASES_K - 1) {
            for (int m = gw; m < M; m += 4 * NGW) rms_row4_b16_f32(MRG + (size_t)m * DM, args.out + (size_t)m * DM, (size_t)NGW * DM, args.in[19], lane);
            ++p; continue;
        }
        const int l = (p - 1) / 8, k = (p - 1) % 8;
        const int dry = 0;
        unsigned char* const wsl = (l == 0) ? ws : wsw1;
        bf16_t* const XS = (bf16_t*)args.out;
        float* const SSQ = (float*)(ws + WS_SSQ);
        if ((AB_MASK & 1) && (k == 0 || k == 6)) {
            pg8::SchedSimple S; S.T.init(M / 256, 2 * FF / 256); S.G = G; S.c = bx; S.A = (const char*)XS; S.B = (const char*)(wsl + (k == 0 ? W_FFN1I : W_FFN2I)); S.lda = 2048; S.ldb = 2048; S.nt = 16;
            pg8::EpiSwiglu E{ACT, SSQ + (size_t)(k == 0 ? 3 * l : 3 * l + 2) * M * 4};
            pg8::gemm_phase(lds, S, E, tid);
        } else if ((AB_MASK & 2) && (k == 1 || k == 7 || k == 5)) {
            pg8::SchedSimple S; S.T.init(M / 256, DM / 256); S.G = G; S.c = bx;
            if (k == 5) { S.A = (const char*)MRG; S.B = (const char*)(wsl + W_OUT); S.lda = 2048; S.ldb = 2048; S.nt = 16; }
            else { S.A = (const char*)ACT; S.B = (const char*)(wsl + (k == 1 ? W_FFN1O : W_FFN2O)); S.lda = FF * 2; S.ldb = FF * 2; S.nt = FF / 64; }
            pg8::EpiResidual E{nullptr, XS, (l == DEPTH - 1 && k == 7) ? MRG : XS, SSQ + (size_t)(3 * l + (k == 1 ? 1 : k == 5 ? 2 : 3)) * M * 4, k == 5 ? 2 : 1};
            pg8::gemm_phase(lds, S, E, tid);
        } else if ((AB_MASK & 4) && k == 2) {
            pg8::SchedProj S; S.T.init(M / 256, PW / 256); S.G = G; S.c = bx; S.XN = (const char*)XS; S.WIN = (const char*)(wsl + W_IN); S.MN = (const char*)MN; S.WMKV = (const char*)(wsl + W_MKV);
            pg8::EpiProj E{P, MKV, (unsigned*)(ws + WS_KNP) + l * 256, SSQ + (size_t)(3 * l + 1) * M * 4};
            pg8::gemm_phase(lds, S, E, tid);
        } else if ((AB_MASK & 8) && k == 3) {
            attention_phase(args, ws, l, lds, vcu, G, tid, dry);
        } else if ((AB_MASK & 16) && k == 4) {
            pg8::SchedBranch S; S.T.init(M / 256, DM / 256); S.G = G; S.c = bx; S.XN = (const char*)XS; S.P = (const char*)P; S.WG = (const char*)(wsl + W_G);
            S.WBD = (const char*)(wsl + W_BRD); S.WBS = (const char*)(wsl + W_BRS); S.WBM = (const char*)(wsl + W_BRM);
            pg8::EpiBranch E{(u32x4*)(ws + WS_G + (size_t)bx * 131072), MRG, SSQ + (size_t)(3 * l + 1) * M * 4, (u32x4*)((unsigned char*)args.out + 64 * MiB + (size_t)bx * 131072)};
            pg8::gemm_phase(lds, S, E, tid);
        }
        if (dry) second = 1; else { second = 0; ++p; }
    }
}

constexpr int N_PHASES = 1 + DEPTH * 8 + 1;

extern "C" void kernel_launch(void* const* d_in, const int* in_sizes, int n_in, void* d_out, int out_size, void* d_ws, size_t ws_size, hipStream_t stream) {
    static int grid = 0;
    if (grid == 0) {
        if (n_in != 20 || out_size != M * DM || ws_size < WS_END) { fprintf(stderr, "kernel_launch: unexpected problem (n_in %d, out %d, ws %zu < %zu)\n", n_in, out_size, ws_size, (size_t)WS_END); grid = -1; return; }
        int dev = 0, cus = 0, per_cu = 0;
        hipGetDevice(&dev); hipDeviceGetAttribute(&cus, hipDeviceAttributeMultiprocessorCount, dev);
        if (hipFuncSetAttribute((const void*)mega_fwd, hipFuncAttributeMaxDynamicSharedMemorySize, LDS_BYTES) != hipSuccess) { fprintf(stderr, "kernel_launch: hipFuncSetAttribute failed\n"); grid = -1; return; }
        hipOccupancyMaxActiveBlocksPerMultiprocessor(&per_cu, (const void*)mega_fwd, NWAVES * 64, LDS_BYTES);
        (void)hipGetLastError();
        if (per_cu < 1) { fprintf(stderr, "kernel_launch: occupancy query says %d blocks per CU\n", per_cu); per_cu = 1; }
        grid = cus;
    }
    if (grid < 0) return;
    if (hipMemsetAsync(d_ws, 0, 65536, stream) != hipSuccess) { fprintf(stderr, "kernel_launch: hipMemsetAsync failed\n"); return; }
    Args a{};
    for (int i = 0; i < 20; ++i) a.in[i] = (const float*)d_in[i];
    a.out = (float*)d_out; a.ws = (unsigned char*)d_ws;
#if MK_N_LAUNCHES == 1
    a.ph_lo = 0; a.ph_hi = N_PHASES;
    void* kargs[] = {&a};
    hipError_t e = hipLaunchCooperativeKernel((const void*)mega_fwd, dim3(grid), dim3(NWAVES * 64), kargs, LDS_BYTES, stream);
    if (e != hipSuccess) fprintf(stderr, "cooperative launch failed: %s (grid %d)\n", hipGetErrorString(e), grid);
#else
    for (int p = 0; p < N_PHASES; ++p) { a.ph_lo = p; a.ph_hi = p + 1; hipLaunchKernelGGL(mega_fwd, dim3(grid), dim3(NWAVES * 64), LDS_BYTES, stream, a); }
#endif
}
```
